# Optimizing an MI355X kernel written in HIP

```python
import jax, jax.numpy as jnp
from jax import lax
import numpy as np

D_MODEL = 1024
BATCH = 4
SEQ = 8192
DEPTH = 2

GRID_W = 64
CTX_LEN = 256
D_MIX = D_MODEL
N_GROUPS = 4
GROUP_W = D_MIX // N_GROUPS
NA_HEADS = 4
NA_HEAD_DIM = GROUP_W // NA_HEADS
NA_WIN_R_MAX = 8
NA_WIN_C = 16
POOL_WINDOWS = (2, 4, 8, 16)
POOL_CH = GROUP_W // len(POOL_WINDOWS)
FNO_GROUPS = 4
FNO_CH = GROUP_W // FNO_GROUPS
MLA_HEADS = 4
MLA_NOPE = 64
MLA_ROPE = 32
MLA_V = GROUP_W // MLA_HEADS
MLA_Q_RANK = 256
MLA_KV_RANK = 128
ROPE_BASE = 10000.0
Q_BLOCK = 128
PROJ_SIZES = (GROUP_W, GROUP_W, GROUP_W, GROUP_W, GROUP_W, MLA_Q_RANK, MLA_KV_RANK, MLA_ROPE)
D_IN = 5 * GROUP_W + MLA_Q_RANK + MLA_KV_RANK + MLA_ROPE
N_EXPERTS = 16
EC_CAPACITY_FACTOR = 2
D_EXPERT = 1024
EPS = 1e-6

kernel_name = 'hybrid_diffusion_parallel_head_groups'


def _rmsnorm(x, g):
    xf = x.astype(jnp.float32)
    y = xf * lax.rsqrt(jnp.mean(xf * xf, axis=-1, keepdims=True) + EPS)
    return (y * g.astype(jnp.float32)).astype(x.dtype)


def _modulate(x, g, shift, scale):
    return _rmsnorm(x, g) * (1 + scale) + shift


def _adaln(cvec, ada_w, ada_b):
    m = jax.nn.silu(cvec) @ ada_w + ada_b
    return jnp.split(m, 6, axis=-1)


def _rotate(v, ang):
    f = ang.shape[-1]
    cos = jnp.cos(ang)[:, None, :].astype(v.dtype)
    sin = jnp.sin(ang)[:, None, :].astype(v.dtype)
    v1, v2 = v[..., :f], v[..., f:]
    return jnp.concatenate([v1 * cos - v2 * sin, v1 * sin + v2 * cos], axis=-1)


def _rope_2d(v):
    n = v.shape[1]
    t = jnp.arange(n)
    rows = (t // GRID_W).astype(jnp.float32)
    cols = (t % GRID_W).astype(jnp.float32)
    half = v.shape[-1] // 2
    nf = half // 2
    inv = ROPE_BASE ** (-jnp.arange(nf, dtype=jnp.float32) / nf)
    return jnp.concatenate([_rotate(v[..., :half], rows[:, None] * inv),
                            _rotate(v[..., half:], cols[:, None] * inv)], axis=-1)


def _heads(t):
    return t.reshape(t.shape[0], t.shape[1], NA_HEADS, NA_HEAD_DIM)


def _neighbourhood_attn(q, k, v, kc, vc, bias_tab):
    B, N, H, dh = q.shape
    rows = N // GRID_W
    win_r = min(NA_WIN_R_MAX, rows)
    scale = dh ** -0.5
    qg = q.reshape(B, rows, GRID_W, H, dh)
    kg = k.reshape(B, rows, GRID_W, H, dh)
    vg = v.reshape(B, rows, GRID_W, H, dh)
    row_start = jnp.clip(jnp.arange(rows) - win_r // 2, 0, rows - win_r)
    col_start = jnp.clip(jnp.arange(GRID_W) - NA_WIN_C // 2, 0, GRID_W - NA_WIN_C)
    col_idx = col_start[:, None] + jnp.arange(NA_WIN_C)
    dc = col_idx - jnp.arange(GRID_W)[:, None] + (NA_WIN_C - 1)
    nw = win_r * NA_WIN_C

    def row_block(args):
        q_row, qy, rs = args
        k_rows = lax.dynamic_slice_in_dim(kg, rs, win_r, axis=1)
        v_rows = lax.dynamic_slice_in_dim(vg, rs, win_r, axis=1)
        k_win = k_rows[:, :, col_idx]
        v_win = v_rows[:, :, col_idx]
        dr = rs + jnp.arange(win_r) - qy + (NA_WIN_R_MAX - 1)
        bias = bias_tab[:, dr][:, :, dc].transpose(0, 2, 1, 3)
        s_win = (jnp.einsum('bqhd,brqjhd->bhqrj', q_row, k_win).astype(jnp.float32) * scale
                 + bias[None].astype(jnp.float32)).reshape(B, H, GRID_W, nw)
        s_ctx = jnp.einsum('bqhd,blhd->bhql', q_row, kc).astype(jnp.float32) * scale
        p = jax.nn.softmax(jnp.concatenate([s_win, s_ctx], axis=-1), axis=-1)
        p_win = p[..., :nw].reshape(B, H, GRID_W, win_r, NA_WIN_C).astype(v.dtype)
        p_ctx = p[..., nw:].astype(v.dtype)
        return (jnp.einsum('bhqrj,brqjhd->bqhd', p_win, v_win)
                + jnp.einsum('bhql,blhd->bqhd', p_ctx, vc))

    out = lax.map(row_block, (qg.transpose(1, 0, 2, 3, 4), jnp.arange(rows), row_start))
    return out.transpose(1, 0, 2, 3, 4).reshape(B, N, H * dh)


def _block_attn(q, k, v, kc, vc):
    B, N, H, d = q.shape
    dv = v.shape[-1]
    scale = d ** -0.5
    nb = N // Q_BLOCK
    qb = q.reshape(B, nb, Q_BLOCK, H, d).transpose(1, 0, 2, 3, 4)

    def body(qblk):
        s_lat = jnp.einsum('bqhd,bkhd->bhqk', qblk, k).astype(jnp.float32) * scale
        s_ctx = jnp.einsum('bqhd,blhd->bhql', qblk, kc).astype(jnp.float32) * scale
        p = jax.nn.softmax(jnp.concatenate([s_lat, s_ctx], axis=-1), axis=-1)
        p_lat = p[..., :N].astype(v.dtype)
        p_ctx = p[..., N:].astype(v.dtype)
        return (jnp.einsum('bhqk,bkhd->bqhd', p_lat, v)
                + jnp.einsum('bhql,blhd->bqhd', p_ctx, vc))

    out = lax.map(body, qb)
    return out.transpose(1, 0, 2, 3, 4).reshape(B, N, H * dv)


def _dense_attn(q, k, v):
    B, L, H, d = q.shape
    s = jnp.einsum('bqhd,bkhd->bhqk', q, k).astype(jnp.float32) * (d ** -0.5)
    p = jax.nn.softmax(s, axis=-1).astype(v.dtype)
    return jnp.einsum('bhqk,bkhd->bqhd', p, v).reshape(B, L, -1)


def _pool_mix(u, pool_w, pool_scale):
    B, N, _ = u.shape
    uf = u.astype(jnp.float32)
    cs = jnp.concatenate([jnp.zeros((B, 1, GROUP_W), jnp.float32), jnp.cumsum(uf, axis=1)], axis=1)
    t = jnp.arange(N)
    outs = []
    for g, w in enumerate(POOL_WINDOWS):
        lo = jnp.clip(t - w // 2, 0, N)
        hi = jnp.clip(t + w - w // 2, 0, N)
        ch = slice(g * POOL_CH, (g + 1) * POOL_CH)
        mean = (cs[:, hi, ch] - cs[:, lo, ch]) / (hi - lo).astype(jnp.float32)[None, :, None]
        outs.append(mean - uf[:, :, ch])
    pooled = jnp.stack(outs, axis=2).astype(u.dtype)
    y = jnp.einsum('bngc,gcd->bngd', pooled, pool_w).reshape(B, N, GROUP_W)
    return y * pool_scale


def _fourier_mix(u, fno_w):
    B, N, _ = u.shape
    ug = u.astype(jnp.float32).reshape(B, N, FNO_GROUPS, FNO_CH)
    f = jnp.fft.fft2(ug, axes=(1, 3), norm='ortho').real
    return f.reshape(B, N, GROUP_W).astype(u.dtype) @ fno_w


def _mla_q(q_c, q_norm, w_uq, positioned):
    B, N, _ = q_c.shape
    q = (_rmsnorm(q_c, q_norm) @ w_uq).reshape(B, N, MLA_HEADS, MLA_NOPE + MLA_ROPE)
    if positioned:
        q = jnp.concatenate([q[..., :MLA_NOPE], _rope_2d(q[..., MLA_NOPE:])], axis=-1)
    return q


def _mla_kv(kv_c, k_r, kv_norm, w_uk, w_uv, positioned):
    B, N, _ = kv_c.shape
    ckv = _rmsnorm(kv_c, kv_norm)
    k_nope = (ckv @ w_uk).reshape(B, N, MLA_HEADS, MLA_NOPE)
    v = (ckv @ w_uv).reshape(B, N, MLA_HEADS, MLA_V)
    k_rope = k_r[:, :, None, :]
    if positioned:
        k_rope = _rope_2d(k_rope)
    k = jnp.concatenate([k_nope, jnp.broadcast_to(k_rope, (B, N, MLA_HEADS, MLA_ROPE))], axis=-1)
    return k, v


def _merge(outs, grp_norm, w_out):
    cat = jnp.concatenate([_rmsnorm(o, grp_norm[g]) for g, o in enumerate(outs)], axis=-1)
    return cat @ w_out


def _mixer(hl, hc, w_in, na_bias, pool_w, pool_scale, fno_w, mla_q_norm, mla_w_uq, mla_kv_norm,
           mla_w_uk, mla_w_uv, grp_norm, w_out, with_ctx):
    cuts = np.cumsum(PROJ_SIZES)[:-1].tolist()
    qa_l, ka_l, va_l, pl_l, fl_l, qc_l, kvc_l, kr_l = jnp.split(hl @ w_in, cuts, axis=-1)
    qa_c, ka_c, va_c, pl_c, fl_c, qc_c, kvc_c, kr_c = jnp.split(hc @ w_in, cuts, axis=-1)
    kD_c, vD_c = _mla_kv(kvc_c, kr_c, mla_kv_norm, mla_w_uk, mla_w_uv, False)
    kD_l, vD_l = _mla_kv(kvc_l, kr_l, mla_kv_norm, mla_w_uk, mla_w_uv, True)
    qD_l = _mla_q(qc_l, mla_q_norm, mla_w_uq, True)
    a_l = _neighbourhood_attn(_heads(qa_l), _heads(ka_l), _heads(va_l), _heads(ka_c), _heads(va_c), na_bias)
    b_l = _pool_mix(pl_l, pool_w, pool_scale)
    c_l = _fourier_mix(fl_l, fno_w)
    d_l = _block_attn(qD_l, kD_l, vD_l, kD_c, vD_c)
    out_l = _merge((a_l, b_l, c_l, d_l), grp_norm, w_out)
    if not with_ctx:
        return out_l, None
    qD_c = _mla_q(qc_c, mla_q_norm, mla_w_uq, False)
    a_c = _dense_attn(_heads(qa_c), _heads(ka_c), _heads(va_c))
    b_c = _pool_mix(pl_c, pool_w, pool_scale)
    c_c = _fourier_mix(fl_c, fno_w)
    d_c = _dense_attn(qD_c, kD_c, vD_c)
    out_c = _merge((a_c, b_c, c_c, d_c), grp_norm, w_out)
    return out_l, out_c


def _ec_moe(h, router_w, w_gate, w_up, w_down):
    B, N, D = h.shape
    aff = jax.nn.softmax((h @ router_w).astype(jnp.float32), axis=-1)
    cap = max(1, EC_CAPACITY_FACTOR * N // N_EXPERTS)
    gates, idx = lax.top_k(jnp.swapaxes(aff, 1, 2), cap)
    bidx = jnp.arange(B)[:, None, None]
    xs = h[bidx, idx]
    hid = (jax.nn.silu(jnp.einsum('becd,edf->becf', xs, w_gate))
           * jnp.einsum('becd,edf->becf', xs, w_up))
    y = jnp.einsum('becf,efd->becd', hid, w_down) * gates[..., None].astype(h.dtype)
    return jnp.zeros_like(h).at[bidx, idx].add(y)


def setup_inputs(seed: int = 0) -> dict:
    key = jax.random.key(seed)
    ks = jax.random.split(key, 26)
    nrm = jax.random.normal
    f32 = jnp.float32
    return {
        'x': nrm(ks[0], (BATCH, SEQ, D_MODEL), f32),
        'c': nrm(ks[1], (BATCH, D_MODEL), f32),
        'ctx': nrm(ks[2], (BATCH, CTX_LEN, D_MODEL), f32),
        'c_ctx': nrm(ks[3], (D_MODEL,), f32),
        'ada_w': nrm(ks[4], (DEPTH, D_MODEL, 6 * D_MODEL), f32) * (0.5 * D_MODEL ** -0.5),
        'ada_b': nrm(ks[5], (DEPTH, 6 * D_MODEL), f32) * 0.02,
        'norm1_g': 1.0 + 0.05 * nrm(ks[6], (DEPTH, D_MODEL), f32),
        'norm2_g': 1.0 + 0.05 * nrm(ks[7], (DEPTH, D_MODEL), f32),
        'w_in': nrm(ks[8], (DEPTH, D_MODEL, D_IN), f32) * D_MODEL ** -0.5,
        'na_bias': nrm(ks[9], (DEPTH, NA_HEADS, 2 * NA_WIN_R_MAX - 1, 2 * NA_WIN_C - 1), f32) * 0.1,
        'pool_w': nrm(ks[10], (DEPTH, len(POOL_WINDOWS), POOL_CH, POOL_CH), f32) * POOL_CH ** -0.5,
        'pool_scale': 1.0 + 0.05 * nrm(ks[11], (DEPTH, GROUP_W), f32),
        'fno_w': nrm(ks[12], (DEPTH, GROUP_W, GROUP_W), f32) * GROUP_W ** -0.5,
        'mla_q_norm': 1.0 + 0.05 * nrm(ks[13], (DEPTH, MLA_Q_RANK), f32),
        'mla_w_uq': nrm(ks[14], (DEPTH, MLA_Q_RANK, MLA_HEADS * (MLA_NOPE + MLA_ROPE)), f32) * MLA_Q_RANK ** -0.5,
        'mla_kv_norm': 1.0 + 0.05 * nrm(ks[15], (DEPTH, MLA_KV_RANK), f32),
        'mla_w_uk': nrm(ks[16], (DEPTH, MLA_KV_RANK, MLA_HEADS * MLA_NOPE), f32) * MLA_KV_RANK ** -0.5,
        'mla_w_uv': nrm(ks[17], (DEPTH, MLA_KV_RANK, MLA_HEADS * MLA_V), f32) * MLA_KV_RANK ** -0.5,
        'grp_norm': 1.0 + 0.05 * nrm(ks[18], (DEPTH, N_GROUPS, GROUP_W), f32),
        'w_out': nrm(ks[19], (DEPTH, D_MIX, D_MODEL), f32) * D_MIX ** -0.5,
        'router_w': nrm(ks[20], (DEPTH, D_MODEL, N_EXPERTS), f32) * D_MODEL ** -0.5,
        'exp_w_gate': nrm(ks[21], (DEPTH, N_EXPERTS, D_MODEL, D_EXPERT), f32) * D_MODEL ** -0.5,
        'exp_w_up': nrm(ks[22], (DEPTH, N_EXPERTS, D_MODEL, D_EXPERT), f32) * D_MODEL ** -0.5,
        'exp_w_down': nrm(ks[23], (DEPTH, N_EXPERTS, D_EXPERT, D_MODEL), f32) * D_EXPERT ** -0.5,
        'final_norm': 1.0 + 0.05 * nrm(ks[24], (D_MODEL,), f32),
    }


def reference(x, c, ctx, c_ctx, ada_w, ada_b, norm1_g, norm2_g, w_in, na_bias, pool_w, pool_scale, fno_w,
              mla_q_norm, mla_w_uq, mla_kv_norm, mla_w_uk, mla_w_uv, grp_norm, w_out, router_w,
              exp_w_gate, exp_w_up, exp_w_down, final_norm):
    xl, xc = x, ctx
    for i in range(DEPTH):
        last = i == DEPTH - 1
        sh1, sc1, gt1, sh2, sc2, gt2 = [m[:, None, :] for m in _adaln(c, ada_w[i], ada_b[i])]
        csh1, csc1, cgt1, csh2, csc2, cgt2 = _adaln(c_ctx, ada_w[i], ada_b[i])
        hl = _modulate(xl, norm1_g[i], sh1, sc1)
        hc = _modulate(xc, norm1_g[i], csh1, csc1)
        mix_l, mix_c = _mixer(hl, hc, w_in[i], na_bias[i], pool_w[i], pool_scale[i], fno_w[i],
                              mla_q_norm[i], mla_w_uq[i], mla_kv_norm[i], mla_w_uk[i], mla_w_uv[i],
                              grp_norm[i], w_out[i], not last)
        xl = xl + gt1 * mix_l
        xl = xl + gt2 * _ec_moe(_modulate(xl, norm2_g[i], sh2, sc2), router_w[i],
                                exp_w_gate[i], exp_w_up[i], exp_w_down[i])
        if not last:
            xc = xc + cgt1 * mix_c
            xc = xc + cgt2 * _ec_moe(_modulate(xc, norm2_g[i], csh2, csc2), router_w[i],
                                     exp_w_gate[i], exp_w_up[i], exp_w_down[i])
    return _rmsnorm(xl, final_norm)
```

```cpp
#include <hip/hip_runtime.h>
#include <hip/hip_cooperative_groups.h>
#include <cstdio>
#include <cstdint>
#include <cmath>
namespace cg = cooperative_groups;

#ifndef MK_ONE_LAUNCH
#define MK_ONE_LAUNCH 1
#endif

#define GAS __attribute__((address_space(1)))
#define LAS __attribute__((address_space(3)))
typedef unsigned short bf16_t;
typedef short bf16x8 __attribute__((ext_vector_type(8)));
typedef short s16x4 __attribute__((ext_vector_type(4)));
typedef float f32x2 __attribute__((ext_vector_type(2)));
typedef float f32x4 __attribute__((ext_vector_type(4)));
typedef float f32x16 __attribute__((ext_vector_type(16)));
typedef unsigned u32x2 __attribute__((ext_vector_type(2)));
typedef unsigned u32x4 __attribute__((ext_vector_type(4)));
typedef __bf16 bf16x2_t __attribute__((ext_vector_type(2)));

constexpr int NBATCH = 4, SEQ = 8192, DM = 1024, CTXL = 256;
constexpr int TL = NBATCH * SEQ, TC = NBATCH * CTXL, TA = TL + TC;
constexpr int DIN = 1696, DINP = 1792;
constexpr int NE = 16, CAPL = 1024, CAPC = 32;
constexpr int NSLOT_L = NBATCH * NE * CAPL;
constexpr int NSLOT = NSLOT_L + NE * 256;
constexpr float EPS = 1e-6f;
constexpr float QSCALE_NA = 0.125f * 1.4426950408889634f, QSCALE_MLA = 0.10206207261596575f * 1.4426950408889634f;
constexpr int PC_AQ = 0, PC_AK = 256, PC_AV = 512, PC_PL = 768, PC_FL = 1024, PC_QC = 1280, PC_KVC = 1536, PC_KR = 1664;
constexpr int CC_A = 0, CC_B = 256, CC_C = 512, CC_D = 768;

constexpr size_t al256(size_t x) { return (x + 255) / 256 * 256; }
constexpr size_t WS_CTL = 0, CTL_BYTES = 1u << 20;
constexpr size_t WS_MODS = WS_CTL + CTL_BYTES;
constexpr size_t WS_ROPE = WS_MODS + al256(2 * 5 * 6144 * 4);
constexpr size_t WS_TW8192 = WS_ROPE + 8192;
constexpr size_t WS_TW256 = WS_TW8192 + 65536;
constexpr size_t WS_R128 = WS_TW256 + 2048;
constexpr size_t WS_R64 = WS_R128 + 65536;
constexpr size_t WS_AFF = WS_R64 + 32768;
constexpr size_t WS_SLOTOF = WS_AFF + al256((size_t)TA * 16 * 4);
constexpr size_t WS_SELTOK = WS_SLOTOF + al256((size_t)TA * 16 * 4);
constexpr size_t WS_SELGATE = WS_SELTOK + al256((size_t)NSLOT * 4);
constexpr size_t WS_SSG = WS_SELGATE + al256((size_t)NSLOT * 4);
constexpr size_t WS_SMALLW = WS_SSG + al256((size_t)TA * 16 * 4);
constexpr size_t SW_WIN = 0;
constexpr size_t SW_WUQ = SW_WIN + (size_t)DINP * 1024 * 2;
constexpr size_t SW_WUKV = SW_WUQ + 512 * 256 * 2;
constexpr size_t SW_POOL = SW_WUKV + 512 * 256 * 2;
constexpr size_t SW_WF = SW_POOL + 256 * 256 * 2;
constexpr size_t SW_WOUT = SW_WF + 512 * 256 * 2;
constexpr size_t SW_BYTES = SW_WOUT + 1024 * 1024 * 2;
constexpr size_t WS_WGU = WS_SMALLW + 2 * SW_BYTES;
constexpr size_t WS_WD = WS_WGU + (size_t)NE * 2048 * 1024 * 2;
constexpr size_t WS_H = WS_WD + (size_t)NE * 1024 * 1024 * 2;
constexpr size_t WS_XC = WS_H + (size_t)TA * 1024 * 2;
constexpr size_t WS_R1 = WS_XC + (size_t)TC * 1024 * 4;
constexpr size_t WS_P = WS_R1;
constexpr size_t WS_QCN = WS_P + (size_t)TA * DINP * 2;
constexpr size_t WS_CKV = WS_QCN + (size_t)TA * 256 * 2;
constexpr size_t WS_POOLA = WS_CKV + (size_t)TA * 256 * 2;
constexpr size_t WS_KR = WS_POOLA + (size_t)TA * 256 * 2;
constexpr size_t WS_R1_END = WS_KR + (size_t)TA * 32 * 2;
constexpr size_t WS_XS = WS_R1;
constexpr size_t WS_YB = WS_R1;
constexpr size_t WS_R2 = WS_R1_END;
constexpr size_t WS_QD = WS_R2;
constexpr size_t WS_KNOPE = WS_QD + (size_t)TA * 384 * 2;
constexpr size_t WS_VD = WS_KNOPE + (size_t)TA * 256 * 2;
constexpr size_t WS_YP = WS_VD + (size_t)TA * 256 * 2;
constexpr size_t YP_CTX_OFF = (size_t)4 * 128 * 128 * 256;
constexpr size_t WS_CAT = WS_YP + (YP_CTX_OFF + (size_t)4 * 4 * 128 * 256) * 2;
constexpr size_t WS_R2_END = WS_CAT + (size_t)TA * 1024 * 2;
constexpr size_t WS_HID = WS_R2;
constexpr size_t WS_XLB = WS_R2_END;
constexpr size_t WS_SSGD = WS_XLB + (size_t)TL * 1024 * 2;
constexpr size_t WS_END = WS_SSGD + al256((size_t)TA * 16 * 4);
static_assert(WS_R1_END - WS_R1 >= (size_t)NSLOT * 1024 * 2, "XS/YB overlay fits R1");
static_assert(WS_R2_END - WS_R2 >= (size_t)NSLOT * 1024 * 2, "HID overlay fits R2");

constexpr int RING_BYTES = 131072;
constexpr int LDSCTL_OFF = RING_BYTES + 8192, MISC_OFF = LDSCTL_OFF + 320;
constexpr int LDS_BYTES = 147456;
constexpr int PTAB_OFF = LDSCTL_OFF + 1024;
extern __shared__ __attribute__((aligned(16))) unsigned char g_lds[];
__device__ __forceinline__ unsigned long long ptab_get(int i) {
    const LAS unsigned* t = (const LAS unsigned*)((LAS unsigned char*)g_lds + PTAB_OFF);
    const unsigned lo = __builtin_amdgcn_readfirstlane(t[2 * i]), hi = __builtin_amdgcn_readfirstlane(t[2 * i + 1]);
    return ((unsigned long long)hi << 32) | lo;
}
__device__ __forceinline__ const float* in_ptr(int i) { return (const float*)ptab_get(i); }
__device__ __forceinline__ float* out_ptr() { return (float*)ptab_get(25); }
__device__ __forceinline__ unsigned char* ws_ptr() { return (unsigned char*)ptab_get(26); }

#define RLX_AGENT __ATOMIC_RELAXED, __HIP_MEMORY_SCOPE_AGENT
#define LDS_WAIT() asm volatile("s_waitcnt lgkmcnt(0)" ::: "memory")
#define SBAR() __builtin_amdgcn_sched_barrier(0)
__device__ __forceinline__ int opaque_tid() { int x = threadIdx.x; asm volatile("" : "+v"(x)); return x; }
__device__ __forceinline__ unsigned pk2(float lo, float hi) { f32x2 v = {lo, hi}; bf16x2_t b = __builtin_convertvector(v, bf16x2_t); return __builtin_bit_cast(unsigned, b); }
__device__ __forceinline__ bf16_t f2bf(float f) { return (bf16_t)(pk2(f, 0.f) & 0xffffu); }
__device__ __forceinline__ float bf2f(unsigned x) { return __uint_as_float(x << 16); }
__device__ __forceinline__ float bflo(unsigned w) { return __uint_as_float(w << 16); }
__device__ __forceinline__ float bfhi(unsigned w) { return __uint_as_float(w & 0xffff0000u); }
template <int CTRL> __device__ __forceinline__ float dpp_mov(float v) { return __builtin_bit_cast(float, __builtin_amdgcn_update_dpp(0, __builtin_bit_cast(int, v), CTRL, 0xF, 0xF, true)); }
__device__ __forceinline__ float wave_sum(float v) {
    v += dpp_mov<0xB1>(v); v += dpp_mov<0x4E>(v); v += dpp_mov<0x141>(v); v += dpp_mov<0x140>(v);
    v += __shfl_xor(v, 16);
    { auto rr = __builtin_amdgcn_permlane32_swap(__float_as_uint(v), __float_as_uint(v), false, false); v = __uint_as_float(rr[0]) + __uint_as_float(rr[1]); }
    return v;
}
__device__ __forceinline__ float xchg32(float v) { auto rr = __builtin_amdgcn_permlane32_swap(__float_as_uint(v), __float_as_uint(v), false, false); return (threadIdx.x & 32) ? __uint_as_float(rr[0]) : __uint_as_float(rr[1]); }
__device__ __forceinline__ float xchg16(float v) { auto rr = __builtin_amdgcn_permlane16_swap(__float_as_uint(v), __float_as_uint(v), false, false); return (threadIdx.x & 16) ? __uint_as_float(rr[0]) : __uint_as_float(rr[1]); }
__device__ __forceinline__ float xchg8(float v) { return dpp_mov<0x128>(v); }
__device__ __forceinline__ float xchg2(float v) { return dpp_mov<0x4E>(v); }
__device__ __forceinline__ float xchg1(float v) { return dpp_mov<0xB1>(v); }
__device__ __forceinline__ float silu_f(float x) { return x / (1.f + __expf(-x)); }

#define XB_TMO      128
#define XB_XCNT(j)  (256  + 64 * (j))
#define XB_XSUB(j)  (1280 + 64 * (j))
#define XB_XGEN(j)  (2304 + 64 * (j))
#define XB_TOP      3328
#define XB_TOPGEN   3392
#define XCD_BAR_WORDS 3456
#define XB_SPIN_CAP (1u << 22)
__device__ __forceinline__ unsigned xb_ld(unsigned* p)              { return __hip_atomic_load(p, __ATOMIC_RELAXED, __HIP_MEMORY_SCOPE_AGENT); }
__device__ __forceinline__ unsigned xb_add(unsigned* p, unsigned v) { return __hip_atomic_fetch_add(p, v, __ATOMIC_RELAXED, __HIP_MEMORY_SCOPE_AGENT); }
__device__ __forceinline__ unsigned xb_xcc_id() { return (unsigned)__builtin_amdgcn_s_getreg((3 << 11) | 20) & 0xFu; }
#define XB_SPIN(cond, bar) do { unsigned _sp = 0; while (cond) { __builtin_amdgcn_s_sleep(1); \
    if ((++_sp & 255u) == 0u) { if (xb_ld(&(bar)[XB_TMO])) break; if (_sp > XB_SPIN_CAP) { atomicAdd(&(bar)[XB_TMO], 1u); break; } } } } while (0)
struct XcdBarrier { unsigned* bar; unsigned x; volatile LAS unsigned* st; };
__device__ __forceinline__ XcdBarrier xcd_barrier_post(unsigned* bar, volatile LAS unsigned* st) {
    XcdBarrier b; b.bar = bar; b.x = xb_xcc_id(); b.st = st;
    if (threadIdx.x == 0) (void)xb_add(&bar[XB_XCNT(b.x)], 1u);
    return b;
}
__device__ __forceinline__ void xcd_barrier_complete(unsigned* bar, unsigned x, unsigned& nloc, unsigned& nx) {
    const unsigned G = gridDim.x * gridDim.y * gridDim.z;
    unsigned sum, cnt, mine, sp = 0u;
    for (;;) {
        sum = 0u; cnt = 0u; mine = 0u;
#pragma unroll
        for (unsigned j = 0; j < 16; ++j) { const unsigned c = xb_ld(&bar[XB_XCNT(j)]); sum += c; cnt += (c > 0u) ? 1u : 0u; mine = (j == x) ? c : mine; }
        if (sum == G) break;
        __builtin_amdgcn_s_sleep(1);
        if ((++sp & 255u) == 0u) { if (xb_ld(&bar[XB_TMO])) break; if (sp > XB_SPIN_CAP) { atomicAdd(&bar[XB_TMO], 1u); break; } }
    }
    nloc = mine > 0u ? mine : 1u; nx = cnt > 0u ? cnt : 1u;
}
__device__ __forceinline__ void xcd_barrier(const XcdBarrier& b) {
    asm volatile("s_waitcnt vmcnt(0)" ::: "memory");
    __syncthreads();
    if (threadIdx.x == 0) {
        unsigned* bar = b.bar;
        __builtin_amdgcn_s_waitcnt(0);
        unsigned nloc = b.st[0], nx = b.st[1];
        if (nloc == 0u) { xcd_barrier_complete(bar, b.x, nloc, nx); b.st[0] = nloc; b.st[1] = nx; }
        const unsigned old = xb_add(&bar[XB_XSUB(b.x)], 1u);
        const unsigned gen = old / nloc;
        if (old + 1u == (gen + 1u) * nloc) {
            __builtin_amdgcn_fence(__ATOMIC_RELEASE, "agent");
            asm volatile("s_waitcnt vmcnt(0)" ::: "memory");
            const unsigned og = xb_add(&bar[XB_TOP], 1u);
            const unsigned tg = og / nx;
            if (og + 1u == (tg + 1u) * nx) xb_add(&bar[XB_TOPGEN], 1u);
            else XB_SPIN(xb_ld(&bar[XB_TOPGEN]) == tg, bar);
            __builtin_amdgcn_fence(__ATOMIC_ACQUIRE, "agent");
            xb_add(&bar[XB_XGEN(b.x)], 1u);
            asm volatile("s_waitcnt vmcnt(0)" ::: "memory");
        } else {
            XB_SPIN(xb_ld(&bar[XB_XGEN(b.x)]) == gen, bar);
            __builtin_amdgcn_fence(__ATOMIC_ACQUIRE, "agent");
            asm volatile("s_waitcnt vmcnt(0)" ::: "memory");
        }
    }
    __syncthreads();
}

namespace pg8 {
constexpr int BM = 256, BK = 64, HALF = 128, HTB = HALF * BK * 2, STAGE_BYTES = 8 * HTB, NXCD = 8, WGM = 8;
__host__ __device__ __forceinline__ int lds_byte(int r, int c) { const int st = (r >> 4) * 2 + (c >> 5), rr = r & 15, cc = c & 31, ob = rr * 64 + cc * 2; return st * 1024 + (ob ^ (((ob >> 9) & 1) << 5)); }
__host__ __device__ __forceinline__ void stage_rc(int b, int& R, int& C) { const int st = b / 1024, sb = b % 1024, swz = sb ^ (((sb >> 9) & 1) << 5); R = (st >> 1) * 16 + swz / 64; C = (st & 1) * 32 + (swz % 64) / 2; }
__host__ __device__ __forceinline__ int perm32(int rho) { const int n = rho >> 4, i = rho & 15; return 8 * (i >> 2) + 4 * n + (i & 3); }
struct Unit { int pm, pn; };
struct Gemm { const bf16_t* A; int lda; const bf16_t* Bt; int K; };
struct Order {
    int nM, nN, nwg, G, c;
    long a_mul;
    int e_div; long e_mul;
    long bn_mul;
    int pm_ctx0; int e_ctx_base;
    int d_mode;
    __device__ void init(int nM_, int nN_, int G_, int c_, long a_mul_, long bn_mul_) { nM = nM_; nN = nN_; nwg = nM * nN; G = G_; c = c_; a_mul = a_mul_; bn_mul = bn_mul_; e_div = 1 << 30; e_mul = 0; pm_ctx0 = 1 << 30; e_ctx_base = 0; d_mode = 0; }
    __device__ bool next(int i, Unit& u) const {
        const long L = (long)i * G + c; if (L >= nwg) return false;
        int wgid = (int)L; { const int q = nwg / NXCD, r = nwg % NXCD, xcd = wgid % NXCD, off = wgid / NXCD; wgid = (xcd < r ? xcd * (q + 1) : r * (q + 1) + (xcd - r) * q) + off; }
        const int nig = WGM * nN, gid = wgid / nig, fm = gid * WGM, gsz = (nM - fm) < WGM ? (nM - fm) : WGM;
        u.pm = fm + ((wgid % nig) % gsz); u.pn = (wgid % nig) / gsz; return true;
    }
    __device__ __forceinline__ long a_off(const Unit& u) const { const long grp = d_mode ? (u.pn < 2 ? 0 : (u.pn < 4 ? 1 : 2)) : 0; return (long)u.pm * a_mul + grp * ((long)TA * 256); }
    __device__ __forceinline__ long b_off(const Unit& u) const { const int e = (u.pm >= pm_ctx0) ? (u.pm - pm_ctx0) : (u.pm / e_div); return (long)e * e_mul + (long)u.pn * bn_mul; }
};

template <class Epi, bool GATHER = false>
__device__ __forceinline__ void gemm_phase(LAS unsigned char* lds, const Gemm g, const Order& S, const Epi& E, const int* rowidx = nullptr) {
    constexpr bool ALIGN_EPI = true;
    const int tid = opaque_tid(), wid = __builtin_amdgcn_readfirstlane(tid >> 6), lane = tid & 63, wr = wid >> 2, wc = wid & 3, fr = lane & 15, fq = lane >> 4;
    const int K = g.K, nt = K / BK, lda = g.lda;
    unsigned voffA[2], voffB[2];
#pragma unroll
    for (int i = 0; i < 2; ++i) { int R, C; stage_rc(tid * 16 + i * 8192, R, C); const int Rb = Epi::PERM ? ((R & ~31) + perm32(R & 31)) : R;
        voffA[i] = (unsigned)(R * lda + C) * 2u; voffB[i] = (unsigned)(Rb * K + C) * 2u; }
    const size_t kstep = (size_t)(BK * 2);
    const size_t hstepA = (size_t)HALF * lda * 2, hstepB = (size_t)HALF * K * 2;
    const unsigned ldsw = (unsigned)wid * 1024u;
    const int aoff = lds_byte(wr * 64 + fr, fq * 8), boff = lds_byte(wc * 32 + fr, fq * 8);
    unsigned vc[2][2], vn[2][2];
    const char* gA = (const char*)g.A;
#define PG8_SA(b, h) (((b) * 2 + (h)) * HTB)
#define PG8_SB(b, h) ((4 + (b) * 2 + (h)) * HTB)
#define PG8_STAGE(bufoff, gbase, voff) do { _Pragma("unroll") for (int _i = 0; _i < 2; ++_i) \
        __builtin_amdgcn_global_load_lds((const unsigned*)((const char*)(gbase) + (voff)[_i]), (LAS unsigned*)(lds + (bufoff) + ldsw + _i * 8192), 16, 0, 0); } while (0)
#define PG8_STA(bufoff, h, nx, kb) do { if constexpr (GATHER) { unsigned o_[2]; o_[0] = (nx) ? vn[h][0] : vc[h][0]; o_[1] = (nx) ? vn[h][1] : vc[h][1]; PG8_STAGE(bufoff, gA + (kb), o_); } \
        else { PG8_STAGE(bufoff, ((nx) ? nA : cA) + (size_t)(h) * hstepA + (kb), voffA); } } while (0)
#define PG8_LOADIDX(dst, unit) do { _Pragma("unroll") for (int i_ = 0; i_ < 2; ++i_) { int R_, C_; stage_rc(tid * 16 + i_ * 8192, R_, C_); \
        _Pragma("unroll") for (int h_ = 0; h_ < 2; ++h_) dst[h_][i_] = (unsigned)rowidx[(unit).pm * BM + h_ * HALF + R_] * (unsigned)(lda * 2) + (unsigned)(C_ * 2); } } while (0)
#define PG8_LDA(dst, b, h) do { _Pragma("unroll") for (int m = 0; m < 4; ++m) _Pragma("unroll") for (int k = 0; k < 2; ++k) dst[m][k] = *(const LAS bf16x8*)(lds + PG8_SA(b, h) + aoff + m * 2048 + k * 1024); } while (0)
#define PG8_LDB(dst, b, h) do { _Pragma("unroll") for (int n = 0; n < 2; ++n) _Pragma("unroll") for (int k = 0; k < 2; ++k) dst[n][k] = *(const LAS bf16x8*)(lds + PG8_SB(b, h) + boff + n * 2048 + k * 1024); } while (0)
#define PG8_MMA(ai, bj, At, Bt) do { __builtin_amdgcn_s_setprio(1); _Pragma("unroll") for (int m = 0; m < 4; ++m) _Pragma("unroll") for (int n = 0; n < 2; ++n) _Pragma("unroll") for (int k = 0; k < 2; ++k) \
        acc[ai][bj][m][n] = __builtin_amdgcn_mfma_f32_16x16x32_bf16(Bt[n][k], At[m][k], acc[ai][bj][m][n], 0, 0, 0); __builtin_amdgcn_s_setprio(0); } while (0)
#define PG8_WAIT_V(n) asm volatile("s_waitcnt vmcnt(" #n ")" ::: "memory")
#define PG8_WAIT_L(n) asm volatile("s_waitcnt lgkmcnt(" #n ")" ::: "memory")
#define PG8_BAR __builtin_amdgcn_s_barrier()
#define PG8_SCHED __builtin_amdgcn_sched_barrier(0)
    Unit cur, nxt; int ui = 0;
    if (!S.next(0, cur)) return;
    f32x4 acc[2][2][4][2];
#pragma unroll
    for (int a = 0; a < 2; ++a)
#pragma unroll
        for (int b = 0; b < 2; ++b)
#pragma unroll
            for (int m = 0; m < 4; ++m)
#pragma unroll
                for (int n = 0; n < 2; ++n) acc[a][b][m][n] = (f32x4){0.f, 0.f, 0.f, 0.f};
    bf16x8 At[4][2], B0[2][2], B1[2][2];
    const char* cA = GATHER ? gA : (const char*)(g.A + S.a_off(cur)); const char* cB = (const char*)(g.Bt + S.b_off(cur));
    const char* nA = cA;
    if constexpr (GATHER) { PG8_LOADIDX(vc, cur); }
    PG8_STAGE(PG8_SB(0, 0), cB, voffB); PG8_STAGE(PG8_SB(0, 1), cB + hstepB, voffB); PG8_STA(PG8_SA(0, 0), 0, false, 0); PG8_STA(PG8_SA(0, 1), 1, false, 0);
    if (wr == 1) PG8_BAR;
    PG8_WAIT_V(2); PG8_BAR;
    PG8_STAGE(PG8_SB(1, 0), cB + kstep, voffB); PG8_STA(PG8_SA(1, 0), 0, false, kstep); PG8_STAGE(PG8_SB(1, 1), cB + hstepB + kstep, voffB);
    PG8_WAIT_V(6); PG8_BAR;
    for (;;) {
        const bool has_next = S.next(ui + 1, nxt);
        if constexpr (GATHER) { if (has_next) { PG8_LOADIDX(vn, nxt); } else { vn[0][0] = vc[0][0]; vn[0][1] = vc[0][1]; vn[1][0] = vc[1][0]; vn[1][1] = vc[1][1]; } }
        else nA = has_next ? (const char*)(g.A + S.a_off(nxt)) : cA;
        const char* nB = has_next ? (const char*)(g.Bt + S.b_off(nxt)) : cB;
#pragma unroll 1
        for (int t = 0; t < nt; t += 2) {
            const bool last = (t == nt - 2);
            const size_t k1 = (size_t)(t + 1) * kstep, k2 = last ? 0 : (size_t)(t + 2) * kstep, k3 = k2 + kstep;
            const char* b2 = last ? nB : cB + (size_t)(t + 2) * kstep; const char* b3 = b2 + kstep;
            PG8_LDB(B0, 0, 0); PG8_LDB(B1, 0, 1); PG8_SCHED; PG8_LDA(At, 0, 0); PG8_STA(PG8_SA(1, 1), 1, false, k1);
            PG8_WAIT_V(8); PG8_WAIT_L(0); PG8_BAR; PG8_MMA(0, 0, At, B0); PG8_MMA(0, 1, At, B1); PG8_BAR; PG8_SCHED;
            PG8_LDA(At, 0, 1); PG8_STAGE(PG8_SB(0, 0), b2, voffB); PG8_STAGE(PG8_SB(0, 1), b2 + hstepB, voffB); PG8_STA(PG8_SA(0, 0), 0, last, k2);
            PG8_WAIT_V(8); PG8_WAIT_L(0); PG8_BAR; PG8_MMA(1, 0, At, B0); PG8_MMA(1, 1, At, B1); PG8_BAR; PG8_SCHED;
            PG8_LDB(B0, 1, 0); PG8_LDB(B1, 1, 1); PG8_SCHED; PG8_LDA(At, 1, 0); PG8_STA(PG8_SA(0, 1), 1, last, k2);
            PG8_WAIT_V(8); PG8_WAIT_L(0); PG8_BAR; PG8_MMA(0, 0, At, B0); PG8_MMA(0, 1, At, B1); PG8_BAR; PG8_SCHED;
            PG8_LDA(At, 1, 1); PG8_STAGE(PG8_SB(1, 0), b3, voffB); PG8_STAGE(PG8_SB(1, 1), b3 + hstepB, voffB); PG8_STA(PG8_SA(1, 0), 0, last, k3);
            PG8_WAIT_V(8); PG8_WAIT_L(0); PG8_BAR; PG8_MMA(1, 0, At, B0); PG8_MMA(1, 1, At, B1); PG8_BAR; PG8_SCHED;
        }
        if constexpr (ALIGN_EPI) { if (wr == 0) PG8_BAR; }
        E(acc, cur, wr, wc, fr, fq);
        if (!has_next) break;
#pragma unroll
        for (int a = 0; a < 2; ++a)
#pragma unroll
            for (int b = 0; b < 2; ++b)
#pragma unroll
                for (int m = 0; m < 4; ++m)
#pragma unroll
                    for (int n = 0; n < 2; ++n) acc[a][b][m][n] = (f32x4){0.f, 0.f, 0.f, 0.f};
        cur = nxt; cA = nA; cB = nB; ++ui;
        if constexpr (GATHER) { vc[0][0] = vn[0][0]; vc[0][1] = vn[0][1]; vc[1][0] = vn[1][0]; vc[1][1] = vn[1][1]; }
        if constexpr (ALIGN_EPI) { if (wr == 1) PG8_BAR; }
    }
    PG8_WAIT_V(0);
    PG8_BAR;
#undef PG8_SA
#undef PG8_SB
#undef PG8_STAGE
#undef PG8_STA
#undef PG8_LOADIDX
#undef PG8_LDA
#undef PG8_LDB
#undef PG8_MMA
#undef PG8_WAIT_V
#undef PG8_WAIT_L
#undef PG8_BAR
#undef PG8_SCHED
}
typedef f32x4 Acc[2][2][4][2];

struct EpiStore {
    static constexpr bool PERM = true;
    bf16_t* O0; int ld0; bf16_t* O1; int ld1; int split_pn;
    __device__ __forceinline__ void operator()(const Acc& acc, const Unit& u, int wr, int wc, int fr, int fq) const {
        const int row0 = u.pm * BM + wr * 64 + fr;
        bf16_t* base; int ld, colt;
        if (u.pn < split_pn) { base = O0; ld = ld0; colt = u.pn * 256; } else { base = O1; ld = ld1; colt = (u.pn - split_pn) * 256; }
        const int col0 = colt + wc * 32 + 8 * fq;
#pragma unroll
        for (int ai = 0; ai < 2; ++ai)
#pragma unroll
            for (int m = 0; m < 4; ++m) { bf16_t* rowp = base + (size_t)(row0 + ai * HALF + m * 16) * ld + col0;
#pragma unroll
                for (int bj = 0; bj < 2; ++bj) { const f32x4 v0 = acc[ai][bj][m][0], v1 = acc[ai][bj][m][1];
                    u32x4 w; w.x = pk2(v0[0], v0[1]); w.y = pk2(v0[2], v0[3]); w.z = pk2(v1[0], v1[1]); w.w = pk2(v1[2], v1[3]);
                    *(u32x4*)(rowp + bj * HALF) = w; } }
    }
};
struct EpiQ {
    static constexpr bool PERM = true;
    bf16_t* O; const float* ropec; const float* ropes;
    __device__ __forceinline__ void operator()(const Acc& acc, const Unit& u, int wr, int wc, int fr, int fq) const {
        const int row0 = u.pm * BM + wr * 64 + fr;
#pragma unroll
        for (int bj = 0; bj < 2; ++bj) {
            const int cb = u.pn * 256 + bj * HALF + wc * 32;
            if (cb >= 384) continue;
            const int hh = cb / 96, dd = cb - hh * 96; const bool rope = (dd == 64);
#pragma unroll
            for (int ai = 0; ai < 2; ++ai)
#pragma unroll
                for (int m = 0; m < 4; ++m) {
                    const int row = row0 + ai * HALF + m * 16;
                    f32x4 v0 = acc[ai][bj][m][0], v1 = acc[ai][bj][m][1];
                    if (rope) {
                        f32x4 p0, p1;
#pragma unroll
                        for (int j = 0; j < 4; ++j) { p0[j] = __shfl_xor(v0[j], 16); p1[j] = __shfl_xor(v1[j], 16); }
                        if (row < TL) {
                            const int t = row & (SEQ - 1); const int pos = (fq < 2) ? (t >> 6) : (t & 63);
                            const f32x4 c0 = *(const f32x4*)(ropec + pos * 8), c1 = *(const f32x4*)(ropec + pos * 8 + 4);
                            const f32x4 s0 = *(const f32x4*)(ropes + pos * 8), s1 = *(const f32x4*)(ropes + pos * 8 + 4);
                            if ((fq & 1) == 0) { v0 = v0 * c0 - p0 * s0; v1 = v1 * c1 - p1 * s1; }
                            else               { v0 = p0 * s0 + v0 * c0; v1 = p1 * s1 + v1 * c1; }
                        }
                    }
                    v0 = v0 * QSCALE_MLA; v1 = v1 * QSCALE_MLA;
                    u32x4 w; w.x = pk2(v0[0], v0[1]); w.y = pk2(v0[2], v0[3]); w.z = pk2(v1[0], v1[1]); w.w = pk2(v1[2], v1[3]);
                    *(u32x4*)(O + (size_t)row * 384 + cb + 8 * fq) = w;
                    asm volatile("" ::: "memory");
                }
        }
    }
};
struct EpiPool {
    static constexpr bool PERM = true;
    bf16_t* O; const float* scale; float* ssg;
    __device__ __forceinline__ void operator()(const Acc& acc, const Unit& u, int wr, int wc, int fr, int fq) const {
        const int row0 = u.pm * BM + wr * 64 + fr; const int col0 = wc * 32 + 8 * fq;
        f32x4 sc[2][2];
#pragma unroll
        for (int bj = 0; bj < 2; ++bj)
#pragma unroll
            for (int n = 0; n < 2; ++n) sc[bj][n] = *(const f32x4*)(scale + col0 + bj * HALF + 4 * n);
#pragma unroll
        for (int ai = 0; ai < 2; ++ai)
#pragma unroll
            for (int m = 0; m < 4; ++m) { const int row = row0 + ai * HALF + m * 16; float ss = 0.f;
#pragma unroll
                for (int bj = 0; bj < 2; ++bj) { const f32x4 v0 = acc[ai][bj][m][0] * sc[bj][0], v1 = acc[ai][bj][m][1] * sc[bj][1];
                    ss += (v0[0] * v0[0] + v0[1] * v0[1]) + (v0[2] * v0[2] + v0[3] * v0[3]) + (v1[0] * v1[0] + v1[1] * v1[1]) + (v1[2] * v1[2] + v1[3] * v1[3]);
                    u32x4 w; w.x = pk2(v0[0], v0[1]); w.y = pk2(v0[2], v0[3]); w.z = pk2(v1[0], v1[1]); w.w = pk2(v1[2], v1[3]);
                    *(u32x4*)(O + (size_t)row * 1024 + CC_B + col0 + bj * HALF) = w; }
                ss += __shfl_xor(ss, 16); ss += __shfl_xor(ss, 32);
                if (fq == 0) ssg[(size_t)row * 16 + 4 + wc] = ss; }
    }
};
struct EpiD {
    static constexpr bool PERM = true;
    EpiQ q; EpiStore kv; EpiPool pool;
    __device__ __forceinline__ void operator()(const Acc& acc, const Unit& u, int wr, int wc, int fr, int fq) const {
        if (u.pn < 2) q(acc, u, wr, wc, fr, fq);
        else if (u.pn < 4) { Unit v = u; v.pn = u.pn - 2; kv(acc, v, wr, wc, fr, fq); }
        else { Unit v = u; v.pn = 0; pool(acc, v, wr, wc, fr, fq); }
    }
};
struct EpiRes {
    static constexpr bool PERM = true;
    const float* baseLf; const bf16_t* baseLb; const float* baseC; bf16_t* outL; float* outC; const float* mods;
    __device__ __forceinline__ void operator()(const Acc& acc, const Unit& u, int wr, int wc, int fr, int fq) const {
        const int row0 = u.pm * BM + wr * 64 + fr; const int col0 = u.pn * BM + wc * 32 + 8 * fq;
        const bool lat = (u.pm * BM < TL); const int bidx = lat ? ((u.pm * BM) >> 13) : 4;
        const float* gp = mods + bidx * 6144 + 2048;
        f32x4 gv[2][2];
#pragma unroll
        for (int bj = 0; bj < 2; ++bj)
#pragma unroll
            for (int n = 0; n < 2; ++n) gv[bj][n] = *(const f32x4*)(gp + col0 + bj * HALF + 4 * n);
#pragma unroll
        for (int ai = 0; ai < 2; ++ai)
#pragma unroll
            for (int m = 0; m < 4; ++m) { const int row = row0 + ai * HALF + m * 16;
#pragma unroll
                for (int bj = 0; bj < 2; ++bj) { const int c = col0 + bj * HALF; f32x4 b0, b1;
                    if (lat) {
                        if (baseLf) { b0 = *(const f32x4*)(baseLf + (size_t)row * 1024 + c); b1 = *(const f32x4*)(baseLf + (size_t)row * 1024 + c + 4); }
                        else { const u32x4 w = *(const u32x4*)(baseLb + (size_t)row * 1024 + c); b0 = (f32x4){bflo(w.x), bfhi(w.x), bflo(w.y), bfhi(w.y)}; b1 = (f32x4){bflo(w.z), bfhi(w.z), bflo(w.w), bfhi(w.w)}; }
                        const f32x4 r0 = b0 + gv[bj][0] * acc[ai][bj][m][0], r1 = b1 + gv[bj][1] * acc[ai][bj][m][1];
                        u32x4 o; o.x = pk2(r0[0], r0[1]); o.y = pk2(r0[2], r0[3]); o.z = pk2(r1[0], r1[1]); o.w = pk2(r1[2], r1[3]);
                        *(u32x4*)(outL + (size_t)row * 1024 + c) = o;
                    } else { const size_t ro = (size_t)(row - TL) * 1024 + c;
                        b0 = *(const f32x4*)(baseC + ro); b1 = *(const f32x4*)(baseC + ro + 4);
                        *(f32x4*)(outC + ro) = b0 + gv[bj][0] * acc[ai][bj][m][0]; *(f32x4*)(outC + ro + 4) = b1 + gv[bj][1] * acc[ai][bj][m][1]; } } }
    }
};
struct EpiSwiGLU {
    static constexpr bool PERM = true;
    bf16_t* O;
    __device__ __forceinline__ void operator()(const Acc& acc, const Unit& u, int wr, int wc, int fr, int fq) const {
        const int row0 = u.pm * BM + wr * 64 + fr; const int col0 = u.pn * 128 + wc * 32 + 8 * fq;
#pragma unroll
        for (int ai = 0; ai < 2; ++ai)
#pragma unroll
            for (int m = 0; m < 4; ++m) { const int row = row0 + ai * HALF + m * 16; float h[8];
#pragma unroll
                for (int n = 0; n < 2; ++n)
#pragma unroll
                    for (int j = 0; j < 4; ++j) { const float gt = acc[ai][0][m][n][j], up = acc[ai][1][m][n][j]; h[n * 4 + j] = gt * __builtin_amdgcn_rcpf(1.f + __expf(-gt)) * up; }
                u32x4 w; w.x = pk2(h[0], h[1]); w.y = pk2(h[2], h[3]); w.z = pk2(h[4], h[5]); w.w = pk2(h[6], h[7]);
                *(u32x4*)(O + (size_t)row * 1024 + col0) = w; }
    }
};
struct EpiGate {
    static constexpr bool PERM = true;
    bf16_t* O; const float* gate;
    __device__ __forceinline__ void operator()(const Acc& acc, const Unit& u, int wr, int wc, int fr, int fq) const {
        const int row0 = u.pm * BM + wr * 64 + fr; const int col0 = u.pn * 256 + wc * 32 + 8 * fq;
#pragma unroll
        for (int ai = 0; ai < 2; ++ai)
#pragma unroll
            for (int m = 0; m < 4; ++m) { const int row = row0 + ai * HALF + m * 16; const float gsc = gate[row];
                bf16_t* rowp = O + (size_t)row * 1024 + col0;
#pragma unroll
                for (int bj = 0; bj < 2; ++bj) { const f32x4 v0 = acc[ai][bj][m][0] * gsc, v1 = acc[ai][bj][m][1] * gsc;
                    u32x4 w; w.x = pk2(v0[0], v0[1]); w.y = pk2(v0[2], v0[3]); w.z = pk2(v1[0], v1[1]); w.w = pk2(v1[2], v1[3]);
                    *(u32x4*)(rowp + bj * HALF) = w; } }
    }
};
}

#define KSWZ(row, colB) ((row) * 256 + ((colB) ^ (((row) & 15) << 4)))
__device__ __forceinline__ int crow(int r, int hi) { return (r & 3) + 8 * (r >> 2) + 4 * hi; }
__device__ __forceinline__ int v_st(int k, int c) { const int kk = (k & ~0xC) | ((k & 4) << 1) | ((k & 8) >> 1); return ((kk >> 3) * 4 + (c >> 5)) * 512 + ((kk & 7) * 32 + (c & 31)) * 2; }
__device__ __forceinline__ int v_rd_base(int lane) { return ((lane & 3) << 3) | (((lane >> 2) & 3) << 6) | (((lane >> 4) & 1) << 5) | (((lane >> 5) & 1) << 8); }
constexpr int v_rd_off(int d0, int ks, int half) { return d0 * 512 + ks * 4096 + half * 2048; }
template <int OFF> __device__ __forceinline__ s16x4 tr_read(int vb) {
    s16x4 r; asm volatile("ds_read_b64_tr_b16 %0, %1 offset:%2" : "=&v"(r) : "v"(vb), "i"(OFF) : "memory"); return r;
}
template <int D0> __device__ __forceinline__ void pv_one(f32x16& od, int vb, bf16x8 pa0, bf16x8 pa1, bf16x8 pa2, bf16x8 pa3) {
    const s16x4 l0 = tr_read<v_rd_off(D0, 0, 0)>(vb), h0 = tr_read<v_rd_off(D0, 0, 1)>(vb), l1 = tr_read<v_rd_off(D0, 1, 0)>(vb), h1 = tr_read<v_rd_off(D0, 1, 1)>(vb);
    const s16x4 l2 = tr_read<v_rd_off(D0, 2, 0)>(vb), h2 = tr_read<v_rd_off(D0, 2, 1)>(vb), l3 = tr_read<v_rd_off(D0, 3, 0)>(vb), h3 = tr_read<v_rd_off(D0, 3, 1)>(vb);
    asm volatile("s_waitcnt lgkmcnt(0)" ::: "memory"); SBAR();
#define PK(L, H) (bf16x8){L[0], L[1], L[2], L[3], H[0], H[1], H[2], H[3]}
    od = __builtin_amdgcn_mfma_f32_32x32x16_bf16(pa0, PK(l0, h0), od, 0, 0, 0);
    od = __builtin_amdgcn_mfma_f32_32x32x16_bf16(pa1, PK(l1, h1), od, 0, 0, 0);
    od = __builtin_amdgcn_mfma_f32_32x32x16_bf16(pa2, PK(l2, h2), od, 0, 0, 0);
    od = __builtin_amdgcn_mfma_f32_32x32x16_bf16(pa3, PK(l3, h3), od, 0, 0, 0);
#undef PK
}
__device__ __forceinline__ void stage_vtile(char* tile, const bf16_t* src, long pitch) {
    const int tid = opaque_tid(), sr = tid >> 4, sc = (tid & 15) * 8;
    const bf16x8 a = *(const bf16x8*)(src + (long)sr * pitch + sc), b = *(const bf16x8*)(src + (long)(32 + sr) * pitch + sc);
    *(bf16x8*)(tile + v_st(sr, sc)) = a; *(bf16x8*)(tile + v_st(32 + sr, sc)) = b;
}

struct AttnDesc {
    unsigned q_off;
    unsigned ka_off, kb_off, v_off;
    unsigned o_off, ss_off;
    int first_base, n_first, second_base, clampmax, NT;
    int qy0, R0;
    int nrows;
};
constexpr int SHM_V = 16384, SHM_K = 16384, ATT_NBUF = 3;
constexpr int ATT_K_OFF = ATT_NBUF * SHM_V, ATT_WS_OFF = ATT_NBUF * (SHM_V + SHM_K), ATT_BIAS_OFF = ATT_WS_OFF + 8 * 64 * 4;

template <int D0> __device__ __forceinline__ void pv_two(f32x16& o0, f32x16& o1, int vb, const bf16x8 (&pa)[2][4]) {
    const s16x4 l0 = tr_read<v_rd_off(D0, 0, 0)>(vb), h0 = tr_read<v_rd_off(D0, 0, 1)>(vb), l1 = tr_read<v_rd_off(D0, 1, 0)>(vb), h1 = tr_read<v_rd_off(D0, 1, 1)>(vb);
    const s16x4 l2 = tr_read<v_rd_off(D0, 2, 0)>(vb), h2 = tr_read<v_rd_off(D0, 2, 1)>(vb), l3 = tr_read<v_rd_off(D0, 3, 0)>(vb), h3 = tr_read<v_rd_off(D0, 3, 1)>(vb);
    asm volatile("s_waitcnt lgkmcnt(0)" ::: "memory"); SBAR();
#define PK(L, H) (bf16x8){L[0], L[1], L[2], L[3], H[0], H[1], H[2], H[3]}
    o0 = __builtin_amdgcn_mfma_f32_32x32x16_bf16(pa[0][0], PK(l0, h0), o0, 0, 0, 0); o1 = __builtin_amdgcn_mfma_f32_32x32x16_bf16(pa[1][0], PK(l0, h0), o1, 0, 0, 0);
    o0 = __builtin_amdgcn_mfma_f32_32x32x16_bf16(pa[0][1], PK(l1, h1), o0, 0, 0, 0); o1 = __builtin_amdgcn_mfma_f32_32x32x16_bf16(pa[1][1], PK(l1, h1), o1, 0, 0, 0);
    o0 = __builtin_amdgcn_mfma_f32_32x32x16_bf16(pa[0][2], PK(l2, h2), o0, 0, 0, 0); o1 = __builtin_amdgcn_mfma_f32_32x32x16_bf16(pa[1][2], PK(l2, h2), o1, 0, 0, 0);
    o0 = __builtin_amdgcn_mfma_f32_32x32x16_bf16(pa[0][3], PK(l3, h3), o0, 0, 0, 0); o1 = __builtin_amdgcn_mfma_f32_32x32x16_bf16(pa[1][3], PK(l3, h3), o1, 0, 0, 0);
#undef PK
}

__device__ __forceinline__ void pv_four(f32x16 (&o)[2][2], int vb, const bf16x8 (&pa)[2][4]) {
    const s16x4 l0 = tr_read<v_rd_off(0, 0, 0)>(vb), h0 = tr_read<v_rd_off(0, 0, 1)>(vb), l1 = tr_read<v_rd_off(0, 1, 0)>(vb), h1 = tr_read<v_rd_off(0, 1, 1)>(vb);
    const s16x4 l2 = tr_read<v_rd_off(0, 2, 0)>(vb), h2 = tr_read<v_rd_off(0, 2, 1)>(vb), l3 = tr_read<v_rd_off(0, 3, 0)>(vb), h3 = tr_read<v_rd_off(0, 3, 1)>(vb);
    const s16x4 m0 = tr_read<v_rd_off(1, 0, 0)>(vb), n0 = tr_read<v_rd_off(1, 0, 1)>(vb), m1 = tr_read<v_rd_off(1, 1, 0)>(vb), n1 = tr_read<v_rd_off(1, 1, 1)>(vb);
    const s16x4 m2 = tr_read<v_rd_off(1, 2, 0)>(vb), n2 = tr_read<v_rd_off(1, 2, 1)>(vb), m3 = tr_read<v_rd_off(1, 3, 0)>(vb), n3 = tr_read<v_rd_off(1, 3, 1)>(vb);
    asm volatile("s_waitcnt lgkmcnt(0)" ::: "memory"); SBAR();
#define PK(L, H) (bf16x8){L[0], L[1], L[2], L[3], H[0], H[1], H[2], H[3]}
#define STEP4(k, LA, HA, LB, HB) do { \
    o[0][0] = __builtin_amdgcn_mfma_f32_32x32x16_bf16(pa[0][k], PK(LA, HA), o[0][0], 0, 0, 0); o[1][0] = __builtin_amdgcn_mfma_f32_32x32x16_bf16(pa[1][k], PK(LA, HA), o[1][0], 0, 0, 0); \
    o[0][1] = __builtin_amdgcn_mfma_f32_32x32x16_bf16(pa[0][k], PK(LB, HB), o[0][1], 0, 0, 0); o[1][1] = __builtin_amdgcn_mfma_f32_32x32x16_bf16(pa[1][k], PK(LB, HB), o[1][1], 0, 0, 0); } while (0)
    STEP4(0, l0, h0, m0, n0); STEP4(1, l1, h1, m1, n1); STEP4(2, l2, h2, m2, n2); STEP4(3, l3, h3, m3, n3);
#undef STEP4
#undef PK
}

template <int DQK, bool NA>
__device__ __forceinline__ void attn_unit(const AttnDesc d, const unsigned char* wsb, char* lds) {
    constexpr int ND = DQK / 16;
    constexpr unsigned LDQ = NA ? DINP : 384, LDKA = NA ? DINP : 256, LDKB = NA ? DINP : 32, LDV = NA ? DINP : 256;
    constexpr float THRL = 8.f * 1.4426950408889634f;
    const int tid = opaque_tid(), wid = __builtin_amdgcn_readfirstlane(tid >> 6), lane = tid & 63, r32 = lane & 31, hi = lane >> 5;
    char* V_lds = lds; char* K_lds = lds + ATT_K_OFF;
    float* wsf = (float*)(lds + ATT_WS_OFF) + wid * 64; float* li_l = wsf; float* al_l = wsf + 32;
    const float* bias = (const float*)(lds + ATT_BIAS_OFF);
    float m_reg[2] = {0.f, 0.f}, l_reg[2] = {0.f, 0.f}; f32x16 o[2][2]; bf16x8 qr[2][ND];
#pragma unroll
    for (int qb = 0; qb < 2; ++qb) { o[qb][0] = f32x16{}; o[qb][1] = f32x16{};
        const bf16_t* Qw = (const bf16_t*)(wsb + d.q_off) + (unsigned)(wid * 64 + qb * 32 + r32) * LDQ + hi * 8;
#pragma unroll
        for (int d0 = 0; d0 < ND; ++d0) qr[qb][d0] = *(const bf16x8*)(Qw + d0 * 16); }
    const int sr = NA ? (tid >> 3) : (tid >> 4), sc = NA ? (tid & 7) * 8 : (tid & 15) * 8, vst0 = v_st(sr, sc), vst1 = v_st(32 + sr, sc);
    const int vb0 = (int)(uintptr_t)V_lds + v_rd_base(lane);
    const unsigned krow = ((sc < 64) ? LDKA : LDKB) * 2u, kcol = (sc < 64) ? d.ka_off + sc * 2u : d.kb_off + ((sc - 64) & 31) * 2u;
    const unsigned vrow = LDV * 2u, vcol = d.v_off + (sc & 63) * 2u;
    const int qy = d.qy0 + wid;
    const int rs = min(max(qy - 4, 0), 120);
    const int NT = d.NT;
    bf16x8 vs0, vs1, ks0, ks1;
#define TOKB(t) (((t) < d.n_first) ? d.first_base + 64 * (t) : d.second_base + 64 * min((t) - d.n_first, d.clampmax))
#define TVALID(t) (true)
#define KLOAD(t) do { const unsigned t0_ = (unsigned)(TOKB(min((t), NT - 1)) + sr); ks0 = *(const bf16x8*)(wsb + (t0_ * krow + kcol)); \
    if constexpr (!NA) ks1 = *(const bf16x8*)(wsb + ((t0_ + 32u) * krow + kcol)); } while (0)
#define VLOAD(t) do { const unsigned t0_ = (unsigned)(TOKB(min((t), NT - 1)) + sr); vs0 = *(const bf16x8*)(wsb + (t0_ * vrow + vcol)); \
    if constexpr (!NA) vs1 = *(const bf16x8*)(wsb + ((t0_ + 32u) * vrow + vcol)); } while (0)
#define KWRITE(b) do { if constexpr (NA) { *(bf16x8*)(K_lds + (b) * SHM_K + KSWZ(sr, sc * 2)) = ks0; } \
    else if (sc < DQK) { *(bf16x8*)(K_lds + (b) * SHM_K + KSWZ(sr, sc * 2)) = ks0; *(bf16x8*)(K_lds + (b) * SHM_K + KSWZ(32 + sr, sc * 2)) = ks1; } } while (0)
#define VWRITE(b) do { if constexpr (NA) { *(bf16x8*)(V_lds + (b) * SHM_V + vst0) = vs0; } \
    else if (sc < 64) { *(bf16x8*)(V_lds + (b) * SHM_V + vst0) = vs0; *(bf16x8*)(V_lds + (b) * SHM_V + vst1) = vs1; } } while (0)
#define VMWAIT() asm volatile("s_waitcnt vmcnt(0)" ::: "memory")
#define PK4(P, BASE, OUT) do { unsigned a0 = pk2(P[BASE + 0], P[BASE + 1]), a1 = pk2(P[BASE + 2], P[BASE + 3]);   \
    unsigned b0 = pk2(P[BASE + 4], P[BASE + 5]), b1 = pk2(P[BASE + 6], P[BASE + 7]);                              \
    auto r0 = __builtin_amdgcn_permlane32_swap(a0, b0, false, false); auto r1 = __builtin_amdgcn_permlane32_swap(a1, b1, false, false); \
    u32x4 w = {r0[0], r1[0], r0[1], r1[1]}; OUT = __builtin_bit_cast(bf16x8, w); } while (0)
    f32x16 p[2][2]; bf16x8 pa[2][4];
    KLOAD(0); VLOAD(0); VMWAIT(); KWRITE(0); VWRITE(0);
    KLOAD(1); VMWAIT(); KWRITE(1);
    KLOAD(2); VLOAD(1);
    __syncthreads();
    if (wid >= 4) __syncthreads();
    int kb = 0, vb = 2;
    for (int j = 0; j < NT; ++j) {
        const bool tv = TVALID(j);
        SBAR(); __builtin_amdgcn_s_setprio(1);
        if (j > 0) pv_four(o, vb0 + vb * SHM_V, pa);
        if (tv) { const char* Ks = K_lds + kb * SHM_K;
            if constexpr (NA) {
                const bool mk = (j >= d.n_first); const int R_ = d.R0 + (j - d.n_first); const bool rowok = (R_ >= rs) && (R_ < rs + 8);
                const float* brow_ = bias + (mk ? min(max(d.R0 + (j - d.n_first) - qy + 7, 0), 14) : 15) * 128 + (63 - r32);
#pragma unroll
                for (int qb = 0; qb < 2; ++qb) { const int cs = min(max(32 * qb + r32 - 8, 0), 48);
#pragma unroll
                    for (int r = 0; r < 16; ++r) { const int kx0 = crow(r, hi), kx1 = kx0 + 32;
                        p[qb][0][r] = (!mk || (rowok && (unsigned)(kx0 - cs) < 16u)) ? brow_[kx0 - 32 * qb] - m_reg[qb] : -INFINITY;
                        p[qb][1][r] = (!mk || (rowok && (unsigned)(kx1 - cs) < 16u)) ? brow_[kx1 - 32 * qb] - m_reg[qb] : -INFINITY; } }
            } else {
#pragma unroll
                for (int qb = 0; qb < 2; ++qb)
#pragma unroll
                    for (int r = 0; r < 16; ++r) { p[qb][0][r] = -m_reg[qb]; p[qb][1][r] = -m_reg[qb]; } }
            bf16x8 kf0 = *(const bf16x8*)(Ks + KSWZ(r32, hi * 16)), kf1 = *(const bf16x8*)(Ks + KSWZ(32 + r32, hi * 16));
#pragma unroll
            for (int d0 = 0; d0 < ND; ++d0) { const bf16x8 b0 = kf0, b1 = kf1;
                if (d0 + 1 < ND) { const int cb = ((d0 + 1) * 16 + hi * 8) * 2; kf0 = *(const bf16x8*)(Ks + KSWZ(r32, cb)); kf1 = *(const bf16x8*)(Ks + KSWZ(32 + r32, cb)); }
                p[0][0] = __builtin_amdgcn_mfma_f32_32x32x16_bf16(b0, qr[0][d0], p[0][0], 0, 0, 0); p[1][0] = __builtin_amdgcn_mfma_f32_32x32x16_bf16(b0, qr[1][d0], p[1][0], 0, 0, 0);
                p[0][1] = __builtin_amdgcn_mfma_f32_32x32x16_bf16(b1, qr[0][d0], p[0][1], 0, 0, 0); p[1][1] = __builtin_amdgcn_mfma_f32_32x32x16_bf16(b1, qr[1][d0], p[1][1], 0, 0, 0); } }
        __builtin_amdgcn_s_setprio(0);
        __syncthreads();
        if (tv) {
#pragma unroll
            for (int qb = 0; qb < 2; ++qb) {
                float pmax = p[qb][0][0];
#pragma unroll
                for (int r = 1; r < 16; ++r) pmax = fmaxf(pmax, p[qb][0][r]);
#pragma unroll
                for (int r = 0; r < 16; ++r) pmax = fmaxf(pmax, p[qb][1][r]);
                { auto rr = __builtin_amdgcn_permlane32_swap(__float_as_uint(pmax), __float_as_uint(pmax), false, false);
                  pmax = fmaxf(__uint_as_float(rr[0]), __uint_as_float(rr[1])); }
                float alpha = 1.f;
                if (__builtin_expect(!__all(pmax <= THRL), 0)) {
                    const float dl = fmaxf(pmax, 0.f); m_reg[qb] += dl; alpha = __builtin_amdgcn_exp2f(-dl);
#pragma unroll
                    for (int r = 0; r < 16; ++r) { p[qb][0][r] -= dl; p[qb][1][r] -= dl; }
                    if (hi == 0) al_l[r32] = alpha; asm volatile("s_waitcnt lgkmcnt(0)" ::: "memory");
#pragma unroll
                    for (int dd = 0; dd < 2; ++dd)
#pragma unroll
                        for (int r = 0; r < 16; ++r) o[qb][dd][r] *= al_l[crow(r, hi)]; }
                float ps0 = 0.f, ps1 = 0.f;
#pragma unroll
                for (int r = 0; r < 16; ++r) { p[qb][0][r] = __builtin_amdgcn_exp2f(p[qb][0][r]); ps0 += p[qb][0][r]; }
#pragma unroll
                for (int r = 0; r < 16; ++r) { p[qb][1][r] = __builtin_amdgcn_exp2f(p[qb][1][r]); ps1 += p[qb][1][r]; }
                float ps = ps0 + ps1;
                { auto rr = __builtin_amdgcn_permlane32_swap(__float_as_uint(ps), __float_as_uint(ps), false, false);
                  ps = __uint_as_float(rr[0]) + __uint_as_float(rr[1]); }
                l_reg[qb] = l_reg[qb] * alpha + ps;
                PK4(p[qb][0], 0, pa[qb][0]); PK4(p[qb][0], 8, pa[qb][1]); PK4(p[qb][1], 0, pa[qb][2]); PK4(p[qb][1], 8, pa[qb][3]);
            }
        } else {
#pragma unroll
            for (int qb = 0; qb < 2; ++qb)
#pragma unroll
                for (int i = 0; i < 4; ++i) pa[qb][i] = (bf16x8){0, 0, 0, 0, 0, 0, 0, 0};
        }
        { const int kw = (kb == 0) ? 2 : kb - 1;
          const int vw = (kb == 2) ? 0 : kb + 1;
          VMWAIT();
          if (j + 2 < NT) KWRITE(kw);
          if (j + 1 < NT) VWRITE(vw);
          KLOAD(j + 3); VLOAD(j + 2); }
        __syncthreads();
        kb = (kb == 2) ? 0 : kb + 1; vb = (vb == 2) ? 0 : vb + 1;
    }
    SBAR();
    pv_four(o, vb0 + vb * SHM_V, pa);
    VMWAIT();
    if (wid < 4) __syncthreads();
#pragma unroll
    for (int qb = 0; qb < 2; ++qb) {
        if (hi == 0) li_l[r32] = l_reg[qb]; asm volatile("s_waitcnt lgkmcnt(0)" ::: "memory");
        const int rowb = wid * 64 + qb * 32;
        bf16_t* Ow = (bf16_t*)(const_cast<unsigned char*>(wsb) + d.o_off) + (unsigned)rowb * 1024u; float* ssw = (float*)(const_cast<unsigned char*>(wsb) + d.ss_off) + rowb * 16;
        if (rowb < d.nrows) {
#pragma unroll
            for (int r = 0; r < 16; ++r) { const int orow = crow(r, hi); const float rl = __builtin_amdgcn_rcpf(li_l[orow]);
                const float v0 = o[qb][0][r] * rl, v1 = o[qb][1][r] * rl;
                Ow[orow * 1024 + r32] = f2bf(v0); Ow[orow * 1024 + 32 + r32] = f2bf(v1);
                float s2 = v0 * v0 + v1 * v1;
                s2 += __shfl_xor(s2, 1); s2 += __shfl_xor(s2, 2); s2 += __shfl_xor(s2, 4); s2 += __shfl_xor(s2, 8); s2 += __shfl_xor(s2, 16);
                if (r32 == 0) ssw[orow * 16] = s2; } }
        asm volatile("s_waitcnt lgkmcnt(0)" ::: "memory");
    }
    __syncthreads();
#undef TOKB
#undef TVALID
#undef KLOAD
#undef VLOAD
#undef KWRITE
#undef VWRITE
#undef VMWAIT
#undef PK4
}

constexpr int MLA_RING = 4, MLA_K_OFF = MLA_RING * SHM_V, MLA_WS_OFF = MLA_RING * (SHM_V + SHM_K);
__device__ __forceinline__ void mla_unit(const AttnDesc d, const unsigned char* wsb, char* lds) {
    constexpr int ND = 6;
    constexpr unsigned LDQ = 384, LDKA = 256, LDKB = 32, LDV = 256;
    constexpr float THRL = 8.f * 1.4426950408889634f;
    const int tid = opaque_tid(), wid = __builtin_amdgcn_readfirstlane(tid >> 6), lane = tid & 63, r32 = lane & 31, hi = lane >> 5;
    char* V_lds = lds; char* K_lds = lds + MLA_K_OFF;
    LAS unsigned char* ldsl_ = (LAS unsigned char*)lds;
    float* wsf = (float*)(lds + MLA_WS_OFF) + wid * 64; float* li_l = wsf; float* al_l = wsf + 32;
    float m_reg[2] = {0.f, 0.f}, l_reg[2] = {0.f, 0.f}; f32x16 o[2][2]; bf16x8 qr[2][ND];
#pragma unroll
    for (int qb = 0; qb < 2; ++qb) { o[qb][0] = f32x16{}; o[qb][1] = f32x16{};
        const bf16_t* Qw = (const bf16_t*)(wsb + d.q_off) + (unsigned)(wid * 64 + qb * 32 + r32) * LDQ + hi * 8;
#pragma unroll
        for (int d0 = 0; d0 < ND; ++d0) qr[qb][d0] = *(const bf16x8*)(Qw + d0 * 16); }
    const int vb0 = (int)(uintptr_t)V_lds + v_rd_base(lane), kbase = (int)(uintptr_t)K_lds;
    int koff[ND];
#pragma unroll
    for (int d0 = 0; d0 < ND; ++d0) koff[d0] = KSWZ(r32, d0 * 32 + hi * 16);
    const int NT = d.NT;
    unsigned kstr[2], kcol[2];
#pragma unroll
    for (int pi = 0; pi < 2; ++pi) { const int row = 8 * wid + 4 * pi + (lane >> 4), c = (lane & 15) ^ (row & 15);
        if (c < 8) { kstr[pi] = LDKA * 2u; kcol[pi] = d.ka_off + (unsigned)c * 16u; }
        else if (c < 12) { kstr[pi] = LDKB * 2u; kcol[pi] = d.kb_off + (unsigned)(c - 8) * 16u; }
        else { kstr[pi] = LDKA * 2u; kcol[pi] = d.ka_off + (unsigned)(c & 7) * 16u; }
        kcol[pi] += (unsigned)row * kstr[pi]; }
    unsigned vcol;
    { const int kk = 8 * wid + ((lane >> 2) & 7), key = (kk & ~0xC) | ((kk & 4) << 1) | ((kk & 8) >> 1), c = 32 * (lane >> 5) + 8 * (lane & 3);
      vcol = d.v_off + (unsigned)key * (LDV * 2u) + (unsigned)c * 2u; }
#define TOKB(t) (((t) < d.n_first) ? d.first_base + 64 * (t) : d.second_base + 64 * min((t) - d.n_first, d.clampmax))
#define K_DMA(t) do { const unsigned tb_ = (unsigned)TOKB(min((t), NT - 1)); const int sl_ = (t) & (MLA_RING - 1); \
        __builtin_amdgcn_global_load_lds((const unsigned*)(wsb + (tb_ * kstr[0] + kcol[0])), (LAS unsigned*)(ldsl_ + MLA_K_OFF + sl_ * SHM_K + wid * 2048), 16, 0, 0); \
        __builtin_amdgcn_global_load_lds((const unsigned*)(wsb + (tb_ * kstr[1] + kcol[1])), (LAS unsigned*)(ldsl_ + MLA_K_OFF + sl_ * SHM_K + wid * 2048 + 1024), 16, 0, 0); } while (0)
#define V_DMA(t) do { const unsigned tb_ = (unsigned)TOKB(min((t), NT - 1)); const int sl_ = (t) & (MLA_RING - 1); \
        __builtin_amdgcn_global_load_lds((const unsigned*)(wsb + (tb_ * (LDV * 2u) + vcol)), (LAS unsigned*)(ldsl_ + sl_ * SHM_V + wid * 2048), 16, 0, 0); } while (0)
#define MBAR() do { asm volatile("s_waitcnt lgkmcnt(0)" ::: "memory"); __builtin_amdgcn_s_barrier(); asm volatile("" ::: "memory"); } while (0)
#define PK4(P, BASE, OUT) do { unsigned a0 = pk2(P[BASE + 0], P[BASE + 1]), a1 = pk2(P[BASE + 2], P[BASE + 3]);   \
    unsigned b0 = pk2(P[BASE + 4], P[BASE + 5]), b1 = pk2(P[BASE + 6], P[BASE + 7]);                              \
    auto r0 = __builtin_amdgcn_permlane32_swap(a0, b0, false, false); auto r1 = __builtin_amdgcn_permlane32_swap(a1, b1, false, false); \
    u32x4 w = {r0[0], r1[0], r0[1], r1[1]}; OUT = __builtin_bit_cast(bf16x8, w); } while (0)
    f32x16 p[2][2]; bf16x8 pa[2][4];
    asm volatile("s_waitcnt vmcnt(0)" ::: "memory");
    K_DMA(0); V_DMA(0); K_DMA(1); V_DMA(1); K_DMA(2);
    asm volatile("s_waitcnt vmcnt(0)" ::: "memory");
    MBAR();
    if (wid >= 4) MBAR();
    int kb = 0, vb = MLA_RING - 1;
    for (int j = 0; j < NT; ++j) {
        SBAR(); __builtin_amdgcn_s_setprio(1);
        { const int va = vb0 + vb * SHM_V, ka = kbase + kb * SHM_K;
          bf16x8 kf[3][2]; f32x16 mn0, mn1;
#define TRD(dst, db, ks, half) asm volatile("ds_read_b64_tr_b16 %0, %1 offset:%2" : "=&v"(dst) : "v"(va), "i"(v_rd_off(db, ks, half)) : "memory")
#define VRD4(ks) do { TRD(vl[ks][0][0], 0, ks, 0); TRD(vl[ks][0][1], 0, ks, 1); TRD(vl[ks][1][0], 1, ks, 0); TRD(vl[ks][1][1], 1, ks, 1); } while (0)
#define KRD2(slot, d0) do { asm volatile("ds_read_b128 %0, %1" : "=&v"(kf[slot][0]) : "v"(ka + koff[d0]) : "memory"); \
                            asm volatile("ds_read_b128 %0, %1 offset:8192" : "=&v"(kf[slot][1]) : "v"(ka + koff[d0]) : "memory"); } while (0)
#define LGKM(n) do { asm volatile("s_waitcnt lgkmcnt(" #n ")" ::: "memory"); SBAR(); } while (0)
#define PK(L, H) (bf16x8){L[0], L[1], L[2], L[3], H[0], H[1], H[2], H[3]}
#define PVSTEP(k) do { const bf16x8 f0_ = PK(vl[k][0][0], vl[k][0][1]), f1_ = PK(vl[k][1][0], vl[k][1][1]); \
    o[0][0] = __builtin_amdgcn_mfma_f32_32x32x16_bf16(pa[0][k], f0_, o[0][0], 0, 0, 0); o[1][0] = __builtin_amdgcn_mfma_f32_32x32x16_bf16(pa[1][k], f0_, o[1][0], 0, 0, 0); \
    o[0][1] = __builtin_amdgcn_mfma_f32_32x32x16_bf16(pa[0][k], f1_, o[0][1], 0, 0, 0); o[1][1] = __builtin_amdgcn_mfma_f32_32x32x16_bf16(pa[1][k], f1_, o[1][1], 0, 0, 0); } while (0)
          if (j > 0) {
              s16x4 vl[4][2][2];
              VRD4(0); VRD4(1); VRD4(2);
              LGKM(8); PVSTEP(0); SBAR();
              VRD4(3);
              LGKM(8); PVSTEP(1); SBAR();
              KRD2(0, 0);
              LGKM(6); PVSTEP(2); SBAR();
              KRD2(1, 1);
              LGKM(4); PVSTEP(3);
#pragma unroll
              for (int r = 0; r < 16; ++r) { mn0[r] = -m_reg[0]; mn1[r] = -m_reg[1]; }
              SBAR();
              KRD2(2, 2);
          } else {
#pragma unroll
              for (int r = 0; r < 16; ++r) { mn0[r] = -m_reg[0]; mn1[r] = -m_reg[1]; }
              KRD2(0, 0); KRD2(1, 1); KRD2(2, 2);
          }
#pragma unroll
          for (int d0 = 0; d0 < ND; ++d0) {
              if (d0 + 2 < ND) LGKM(4); else if (d0 + 1 < ND) LGKM(2); else LGKM(0);
              const bf16x8 b0 = kf[d0 % 3][0], b1 = kf[d0 % 3][1];
              if (d0 == 0) {
                  p[0][0] = __builtin_amdgcn_mfma_f32_32x32x16_bf16(b0, qr[0][0], mn0, 0, 0, 0); p[1][0] = __builtin_amdgcn_mfma_f32_32x32x16_bf16(b0, qr[1][0], mn1, 0, 0, 0);
                  p[0][1] = __builtin_amdgcn_mfma_f32_32x32x16_bf16(b1, qr[0][0], mn0, 0, 0, 0); p[1][1] = __builtin_amdgcn_mfma_f32_32x32x16_bf16(b1, qr[1][0], mn1, 0, 0, 0);
              } else {
                  p[0][0] = __builtin_amdgcn_mfma_f32_32x32x16_bf16(b0, qr[0][d0], p[0][0], 0, 0, 0); p[1][0] = __builtin_amdgcn_mfma_f32_32x32x16_bf16(b0, qr[1][d0], p[1][0], 0, 0, 0);
                  p[0][1] = __builtin_amdgcn_mfma_f32_32x32x16_bf16(b1, qr[0][d0], p[0][1], 0, 0, 0); p[1][1] = __builtin_amdgcn_mfma_f32_32x32x16_bf16(b1, qr[1][d0], p[1][1], 0, 0, 0);
              }
              SBAR();
              if (d0 + 3 < ND) KRD2(d0 % 3, d0 + 3);
          }
#undef TRD
#undef VRD4
#undef KRD2
#undef LGKM
#undef PK
#undef PVSTEP
        }
        __builtin_amdgcn_s_setprio(0);
        asm volatile("s_waitcnt vmcnt(3)" ::: "memory");
        MBAR();
        K_DMA(j + 3); V_DMA(j + 2);
#pragma unroll
        for (int qb = 0; qb < 2; ++qb) {
            float pmax = p[qb][0][0];
#pragma unroll
            for (int r = 1; r < 16; ++r) pmax = fmaxf(pmax, p[qb][0][r]);
#pragma unroll
            for (int r = 0; r < 16; ++r) pmax = fmaxf(pmax, p[qb][1][r]);
            { auto rr = __builtin_amdgcn_permlane32_swap(__float_as_uint(pmax), __float_as_uint(pmax), false, false);
              pmax = fmaxf(__uint_as_float(rr[0]), __uint_as_float(rr[1])); }
            float alpha = 1.f;
            if (__builtin_expect(!__all(pmax <= THRL), 0)) {
                const float dl = fmaxf(pmax, 0.f); m_reg[qb] += dl; alpha = __builtin_amdgcn_exp2f(-dl);
#pragma unroll
                for (int r = 0; r < 16; ++r) { p[qb][0][r] -= dl; p[qb][1][r] -= dl; }
                if (hi == 0) al_l[r32] = alpha; asm volatile("s_waitcnt lgkmcnt(0)" ::: "memory");
#pragma unroll
                for (int dd = 0; dd < 2; ++dd)
#pragma unroll
                    for (int r = 0; r < 16; ++r) o[qb][dd][r] *= al_l[crow(r, hi)]; }
            float ps0 = 0.f, ps1 = 0.f;
#pragma unroll
            for (int r = 0; r < 16; ++r) { p[qb][0][r] = __builtin_amdgcn_exp2f(p[qb][0][r]); ps0 += p[qb][0][r]; }
#pragma unroll
            for (int r = 0; r < 16; ++r) { p[qb][1][r] = __builtin_amdgcn_exp2f(p[qb][1][r]); ps1 += p[qb][1][r]; }
            float ps = ps0 + ps1;
            { auto rr = __builtin_amdgcn_permlane32_swap(__float_as_uint(ps), __float_as_uint(ps), false, false);
              ps = __uint_as_float(rr[0]) + __uint_as_float(rr[1]); }
            l_reg[qb] = l_reg[qb] * alpha + ps;
            PK4(p[qb][0], 0, pa[qb][0]); PK4(p[qb][0], 8, pa[qb][1]); PK4(p[qb][1], 0, pa[qb][2]); PK4(p[qb][1], 8, pa[qb][3]);
        }
        MBAR();
        kb = (kb + 1) & (MLA_RING - 1); vb = (vb + 1) & (MLA_RING - 1);
    }
    SBAR();
    pv_four(o, vb0 + vb * SHM_V, pa);
    asm volatile("s_waitcnt vmcnt(0)" ::: "memory");
    if (wid < 4) MBAR();
#pragma unroll
    for (int qb = 0; qb < 2; ++qb) {
        if (hi == 0) li_l[r32] = l_reg[qb]; asm volatile("s_waitcnt lgkmcnt(0)" ::: "memory");
        const int rowb = wid * 64 + qb * 32;
        bf16_t* Ow = (bf16_t*)(const_cast<unsigned char*>(wsb) + d.o_off) + (unsigned)rowb * 1024u; float* ssw = (float*)(const_cast<unsigned char*>(wsb) + d.ss_off) + rowb * 16;
        if (rowb < d.nrows) {
#pragma unroll
            for (int r = 0; r < 16; ++r) { const int orow = crow(r, hi); const float rl = __builtin_amdgcn_rcpf(li_l[orow]);
                const float v0 = o[qb][0][r] * rl, v1 = o[qb][1][r] * rl;
                Ow[orow * 1024 + r32] = f2bf(v0); Ow[orow * 1024 + 32 + r32] = f2bf(v1);
                float s2 = v0 * v0 + v1 * v1;
                s2 += __shfl_xor(s2, 1); s2 += __shfl_xor(s2, 2); s2 += __shfl_xor(s2, 4); s2 += __shfl_xor(s2, 8); s2 += __shfl_xor(s2, 16);
                if (r32 == 0) ssw[orow * 16] = s2; } }
        asm volatile("s_waitcnt lgkmcnt(0)" ::: "memory");
    }
    __syncthreads();
#undef TOKB
#undef K_DMA
#undef V_DMA
#undef MBAR
#undef PK4
}

struct AttnDesc1 {
    unsigned q_off;
    unsigned ka_off, kb_off, v_off;
    unsigned o_off, ss_off;
    int first_base, n_first, second_base, clampmax, NT;
    int qy0, R0;
};
constexpr int ATT1_WS_OFF = 2 * SHM_V + 2 * SHM_K, ATT1_BIAS_OFF = ATT1_WS_OFF + 8 * 64 * 4;

template <int DQK, bool NA>
__device__ __forceinline__ void attn_unit_v1(const AttnDesc1 d, const unsigned char* wsb, char* lds) {
    constexpr int ND = DQK / 16;
    constexpr unsigned LDQ = NA ? DINP : 384, LDKA = NA ? DINP : 256, LDKB = NA ? DINP : 32, LDV = NA ? DINP : 256;
    const float C = 1.0f;
    const float THRL1 = 8.f * 1.4426950408889634f;
    const int tid = opaque_tid(), wid = tid >> 6, lane = tid & 63, r32 = lane & 31, hi = lane >> 5;
    bf16_t* V_lds = (bf16_t*)lds; bf16_t* K_lds = (bf16_t*)(lds + 2 * SHM_V);
    float* wsf = (float*)(lds + ATT1_WS_OFF) + wid * 64; float* li_l = wsf; float* al_l = wsf + 32;
    const float* bias = (const float*)(lds + ATT1_BIAS_OFF);
    float m_reg = -1e30f, l_reg = 0; f32x16 o[2]; o[0] = f32x16{}; o[1] = f32x16{}; bf16x8 qr[ND];
    { const bf16_t* Qw = (const bf16_t*)(wsb + d.q_off) + (unsigned)(wid * 32 + r32) * LDQ + hi * 8;
#pragma unroll
      for (int d0 = 0; d0 < ND; ++d0) qr[d0] = *(const bf16x8*)(Qw + d0 * 16); }
    const int sr = NA ? (tid >> 3) : (tid >> 4), sc = NA ? (tid & 7) * 8 : (tid & 15) * 8, vst0 = v_st(sr, sc), vst1 = v_st(32 + sr, sc);
    const int vb0 = (int)(uintptr_t)V_lds + v_rd_base(lane);
    const unsigned krow = ((sc < 64) ? LDKA : LDKB) * 2u, kcol = (sc < 64) ? d.ka_off + sc * 2u : d.kb_off + ((sc - 64) & 31) * 2u;
    const unsigned vrow = LDV * 2u, vcol = d.v_off + (sc & 63) * 2u;
    const int qy = d.qy0 + (wid >> 1), qx = 32 * (wid & 1) + r32;
    const int rs = min(max(qy - 4, 0), 120), cs = min(max(qx - 8, 0), 48);
    bf16x8 vs0, vs1, ks0, ks1;
#define TOKB(t) (((t) < d.n_first) ? d.first_base + 64 * (t) : d.second_base + 64 * min((t) - d.n_first, d.clampmax))
#define SLOAD(t) do { const unsigned t0_ = (unsigned)(TOKB(t) + sr); \
    vs0 = *(const bf16x8*)(wsb + (t0_ * vrow + vcol)); ks0 = *(const bf16x8*)(wsb + (t0_ * krow + kcol)); \
    if constexpr (!NA) { vs1 = *(const bf16x8*)(wsb + ((t0_ + 32u) * vrow + vcol)); ks1 = *(const bf16x8*)(wsb + ((t0_ + 32u) * krow + kcol)); } } while (0)
#define SWRITE(b) do { if constexpr (NA) { *(bf16x8*)((char*)V_lds + (b) * SHM_V + vst0) = vs0; *(bf16x8*)((char*)K_lds + (b) * SHM_K + KSWZ(sr, sc * 2)) = ks0; } else { if (sc < 64) { *(bf16x8*)((char*)V_lds + (b) * SHM_V + vst0) = vs0; *(bf16x8*)((char*)V_lds + (b) * SHM_V + vst1) = vs1; } \
    if (sc < DQK) { const int kc = sc * 2; *(bf16x8*)((char*)K_lds + (b) * SHM_K + KSWZ(sr, kc)) = ks0; *(bf16x8*)((char*)K_lds + (b) * SHM_K + KSWZ(32 + sr, kc)) = ks1; } } } while (0)
#define SWAIT() asm volatile("s_waitcnt vmcnt(0)" ::: "memory")
#define RESC(a) do { if (__any((a) < 1.f)) { if (hi == 0) al_l[r32] = (a); asm volatile("s_waitcnt lgkmcnt(0)" ::: "memory"); \
    _Pragma("unroll") for (int dd = 0; dd < 2; ++dd) _Pragma("unroll") for (int r = 0; r < 16; ++r) o[dd][r] *= al_l[crow(r, hi)]; } } while (0)
#define QKT(p0, p1, Ks) do { p0 = f32x16{}; p1 = f32x16{}; \
    _Pragma("unroll") for (int d0 = 0; d0 < ND; ++d0) { const int cb = (d0 * 16 + hi * 8) * 2; \
        const bf16x8 b0 = *(const bf16x8*)((const char*)(Ks) + KSWZ(r32, cb)); \
        const bf16x8 b1 = *(const bf16x8*)((const char*)(Ks) + KSWZ(32 + r32, cb)); \
        p0 = __builtin_amdgcn_mfma_f32_32x32x16_bf16(b0, qr[d0], p0, 0, 0, 0); \
        p1 = __builtin_amdgcn_mfma_f32_32x32x16_bf16(b1, qr[d0], p1, 0, 0, 0); } } while (0)
#define NAMOD(p0, p1, t) do { if constexpr (NA) { if ((t) >= d.n_first) { \
        const int R_ = d.R0 + ((t) - d.n_first); const bool tv_ = (R_ >= rs) && (R_ < rs + 8); \
        const float* brow_ = bias + min(max(R_ - qy + 7, 0), 14) * 128 + (63 - qx); \
        _Pragma("unroll") for (int r = 0; r < 16; ++r) { \
            const int kx0 = crow(r, hi), kx1 = kx0 + 32; \
            const bool ok0 = tv_ && ((unsigned)(kx0 - cs) < 16u), ok1 = tv_ && ((unsigned)(kx1 - cs) < 16u); \
            p0[r] = ok0 ? p0[r] + brow_[kx0] : -INFINITY; \
            p1[r] = ok1 ? p1[r] + brow_[kx1] : -INFINITY; \
            if ((r & 3) == 3) asm volatile("" ::: "memory"); } } } } while (0)
#define PARTIALSM(p0, p1, mn, alpha) do { \
    float pmax = p0[0]; \
    _Pragma("unroll") for (int r = 1; r < 16; ++r) pmax = fmaxf(pmax, p0[r]); \
    _Pragma("unroll") for (int r = 0; r < 16; ++r) pmax = fmaxf(pmax, p1[r]); \
    { auto rr = __builtin_amdgcn_permlane32_swap(__float_as_uint(pmax), __float_as_uint(pmax), false, false); \
      pmax = fmaxf(__uint_as_float(rr[0]), __uint_as_float(rr[1])); } \
    if (__builtin_expect(__all(pmax - m_reg <= THRL1), 1)) { mn = m_reg; alpha = 1.f; } \
    else { mn = fmaxf(m_reg, pmax); alpha = __builtin_amdgcn_exp2f((m_reg - mn) * C); m_reg = mn; } \
    const float mnC = -mn * C; \
    _Pragma("unroll") for (int r = 0; r < 16; ++r) p0[r] = fmaf(p0[r], C, mnC); \
    _Pragma("unroll") for (int r = 0; r < 16; ++r) p1[r] = fmaf(p1[r], C, mnC); \
    _Pragma("unroll") for (int r = 0; r < 16; ++r) p0[r] = __builtin_amdgcn_exp2f(p0[r]); } while (0)
#define PK4(P, BASE, OUT) do { unsigned a0 = pk2(P[BASE + 0], P[BASE + 1]), a1 = pk2(P[BASE + 2], P[BASE + 3]);   \
    unsigned b0 = pk2(P[BASE + 4], P[BASE + 5]), b1 = pk2(P[BASE + 6], P[BASE + 7]);                              \
    auto r0 = __builtin_amdgcn_permlane32_swap(a0, b0, false, false); auto r1 = __builtin_amdgcn_permlane32_swap(a1, b1, false, false); \
    u32x4 w = {r0[0], r1[0], r0[1], r1[1]}; OUT = __builtin_bit_cast(bf16x8, w); } while (0)
#define FINISHSM(p0, p1, alpha) do { \
    _Pragma("unroll") for (int r = 0; r < 16; ++r) p1[r] = __builtin_amdgcn_exp2f(p1[r]); \
    float ps = 0; \
    _Pragma("unroll") for (int r = 0; r < 16; ++r) ps += p0[r]; \
    _Pragma("unroll") for (int r = 0; r < 16; ++r) ps += p1[r]; \
    { auto rr = __builtin_amdgcn_permlane32_swap(__float_as_uint(ps), __float_as_uint(ps), false, false); \
      ps = __uint_as_float(rr[0]) + __uint_as_float(rr[1]); } \
    l_reg = l_reg * alpha + ps; \
    PK4(p0, 0, pa0); PK4(p0, 8, pa1); PK4(p1, 0, pa2); PK4(p1, 8, pa3); } while (0)
#define PV2(vb) do { pv_one<0>(o[0], (vb), pa0, pa1, pa2, pa3); pv_one<1>(o[1], (vb), pa0, pa1, pa2, pa3); } while (0)

    f32x16 pA0, pA1, pB0, pB1; float mnA, mnB, alA, alB; bf16x8 pa0, pa1, pa2, pa3; const int NT = d.NT;
    const bf16_t* K1_lds = (const bf16_t*)((const char*)K_lds + SHM_K);
    SLOAD(0); SWAIT(); SWRITE(0); __syncthreads();
    QKT(pA0, pA1, K_lds); NAMOD(pA0, pA1, 0); PARTIALSM(pA0, pA1, mnA, alA);
    SLOAD(1); SWAIT(); SWRITE(1); __syncthreads();
    for (int j = 1; j + 1 < NT; j += 2) {
        SBAR(); QKT(pB0, pB1, K1_lds); NAMOD(pB0, pB1, j);
        FINISHSM(pA0, pA1, alA); SBAR();
        SLOAD(j + 1); SBAR();
        PV2(vb0); PARTIALSM(pB0, pB1, mnB, alB);
        __syncthreads(); SWAIT(); SWRITE(0);
        RESC(alB); __syncthreads();
        SBAR(); QKT(pA0, pA1, K_lds); NAMOD(pA0, pA1, j + 1);
        FINISHSM(pB0, pB1, alB); SBAR();
        SLOAD(j + 2); SBAR();
        PV2(vb0 + SHM_V); PARTIALSM(pA0, pA1, mnA, alA);
        __syncthreads(); SWAIT(); SWRITE(1);
        RESC(alA); __syncthreads();
    }
    SBAR(); QKT(pB0, pB1, K1_lds); NAMOD(pB0, pB1, NT - 1);
    FINISHSM(pA0, pA1, alA); SBAR();
    PV2(vb0); PARTIALSM(pB0, pB1, mnB, alB);
    __syncthreads(); RESC(alB);
    FINISHSM(pB0, pB1, alB); SBAR();
    PV2(vb0 + SHM_V);
    if (hi == 0) li_l[r32] = l_reg; asm volatile("s_waitcnt lgkmcnt(0)" ::: "memory");
    bf16_t* Ow = (bf16_t*)(const_cast<unsigned char*>(wsb) + d.o_off) + (unsigned)(wid * 32) * 1024u; float* ssw = (float*)(const_cast<unsigned char*>(wsb) + d.ss_off) + (wid * 32) * 16;
#pragma unroll
    for (int r = 0; r < 16; ++r) { const int orow = crow(r, hi); const float rl = __builtin_amdgcn_rcpf(li_l[orow]);
        const float v0 = o[0][r] * rl, v1 = o[1][r] * rl;
        Ow[orow * 1024 + r32] = f2bf(v0); Ow[orow * 1024 + 32 + r32] = f2bf(v1);
        float s2 = v0 * v0 + v1 * v1;
        s2 += __shfl_xor(s2, 1); s2 += __shfl_xor(s2, 2); s2 += __shfl_xor(s2, 4); s2 += __shfl_xor(s2, 8); s2 += __shfl_xor(s2, 16);
        if (r32 == 0) ssw[orow * 16] = s2; }
    __syncthreads();
#undef TOKB
#undef SLOAD
#undef SWRITE
#undef SWAIT
#undef RESC
#undef QKT
#undef NAMOD
#undef PARTIALSM
#undef PK4
#undef FINISHSM
#undef PV2
}

struct NaDesc {
    unsigned q_off, k_off, v_off, o_off, ss_off;
    int ctx_base;
    int row_base, R0, nrows;
    int qy0;
};
constexpr int NA_KOFF = 0, NA_VOFF = 32768, NA_BIAS_OFF = 65536;
struct NaChain { bf16x8 qf[2]; f32x4 o[4]; float m, l; };
template <bool MASKED>
__device__ __forceinline__ void na_softmax(NaChain& C, f32x4& s0, f32x4& s1, const float* br, int kb0, int g, int cs, bf16x8& pf, float& al) {
    if constexpr (MASKED) {
#pragma unroll
        for (int r = 0; r < 4; ++r) { const int kx0 = kb0 + 4 * g + r, kx1 = kx0 + 16; const float b0_ = br[kx0], b1_ = br[kx1];
            s0[r] = ((unsigned)(kx0 - cs) < 16u) ? s0[r] + b0_ : -INFINITY; s1[r] = ((unsigned)(kx1 - cs) < 16u) ? s1[r] + b1_ : -INFINITY; } }
    float pm = fmaxf(fmaxf(fmaxf(s0[0], s0[1]), fmaxf(s0[2], s0[3])), fmaxf(fmaxf(s1[0], s1[1]), fmaxf(s1[2], s1[3])));
    pm = fmaxf(pm, xchg16(pm)); pm = fmaxf(pm, xchg32(pm));
    const float mn = fmaxf(C.m, pm); al = __builtin_amdgcn_exp2f(C.m - mn); C.m = mn;
    float ps = 0.f;
#pragma unroll
    for (int r = 0; r < 4; ++r) { s0[r] = __builtin_amdgcn_exp2f(s0[r] - mn); s1[r] = __builtin_amdgcn_exp2f(s1[r] - mn); ps += s0[r] + s1[r]; }
    C.l = C.l * al + ps;
    u32x4 pw; pw.x = pk2(s0[0], s0[1]); pw.y = pk2(s0[2], s0[3]); pw.z = pk2(s1[0], s1[1]); pw.w = pk2(s1[2], s1[3]);
    pf = __builtin_bit_cast(bf16x8, pw);
}
template <bool MASKED, bool DOA, bool DOB>
__device__ __forceinline__ void na_step(NaChain& A, NaChain& B, const char* Kt, const char* Vt, int kb0, const float* brA, const float* brB, int q, int g, int cs) {
    f32x4 sA0 = (f32x4){0.f, 0.f, 0.f, 0.f}, sA1 = sA0, sB0 = sA0, sB1 = sA0;
#pragma unroll
    for (int s = 0; s < 2; ++s) {
        const int r0 = kb0 + q, r1 = r0 + 16;
        const bf16x8 a0 = *(const bf16x8*)(Kt + r0 * 128 + (((4 * s + g) ^ (r0 & 7)) << 4));
        const bf16x8 a1 = *(const bf16x8*)(Kt + r1 * 128 + (((4 * s + g) ^ (r1 & 7)) << 4));
        if constexpr (DOA) { sA0 = __builtin_amdgcn_mfma_f32_16x16x32_bf16(a0, A.qf[s], sA0, 0, 0, 0); sA1 = __builtin_amdgcn_mfma_f32_16x16x32_bf16(a1, A.qf[s], sA1, 0, 0, 0); }
        if constexpr (DOB) { sB0 = __builtin_amdgcn_mfma_f32_16x16x32_bf16(a0, B.qf[s], sB0, 0, 0, 0); sB1 = __builtin_amdgcn_mfma_f32_16x16x32_bf16(a1, B.qf[s], sB1, 0, 0, 0); } }
    bf16x8 pfA, pfB; float alA = 1.f, alB = 1.f;
    if constexpr (DOA) na_softmax<MASKED>(A, sA0, sA1, brA, kb0, g, cs, pfA, alA);
    if constexpr (DOB) na_softmax<MASKED>(B, sB0, sB1, brB, kb0, g, cs, pfB, alB);
    s16x4 t0_[4], t1_[4];
#pragma unroll
    for (int c = 0; c < 4; ++c) {
        const int k0 = kb0 + 4 * g + (q >> 2), k1 = k0 + 16; const int c16 = 2 * c + ((q & 3) >> 1);
        const int ad0 = (int)(uintptr_t)(Vt + k0 * 128 + ((c16 ^ (k0 & 7)) << 4) + (q & 1) * 8), ad1 = (int)(uintptr_t)(Vt + k1 * 128 + ((c16 ^ (k1 & 7)) << 4) + (q & 1) * 8);
        t0_[c] = tr_read<0>(ad0); t1_[c] = tr_read<0>(ad1); }
    asm volatile("s_waitcnt lgkmcnt(0)" ::: "memory"); SBAR();
#pragma unroll
    for (int c = 0; c < 4; ++c) {
        const bf16x8 vf = (bf16x8){t0_[c][0], t0_[c][1], t0_[c][2], t0_[c][3], t1_[c][0], t1_[c][1], t1_[c][2], t1_[c][3]};
        if constexpr (DOA) { A.o[c] = A.o[c] * alA; A.o[c] = __builtin_amdgcn_mfma_f32_16x16x32_bf16(vf, pfA, A.o[c], 0, 0, 0); }
        if constexpr (DOB) { B.o[c] = B.o[c] * alB; B.o[c] = __builtin_amdgcn_mfma_f32_16x16x32_bf16(vf, pfB, B.o[c], 0, 0, 0); } }
}
__device__ __forceinline__ void na_unit(const NaDesc d, const unsigned char* wsb, char* lds) {
    const int tid = opaque_tid(), wid = __builtin_amdgcn_readfirstlane(tid >> 6), lane = tid & 63, q = lane & 15, g = lane >> 4;
    const int seg = wid & 3, qyA = d.qy0 + (wid >> 2), qyB = qyA + 2, qx = 16 * seg + q;
    const int cstart = (seg == 0) ? 0 : (seg == 1 ? 8 : (seg == 2 ? 24 : 32));
    const int rsA = min(max(qyA - 4, 0), 120), rsB = min(max(qyB - 4, 0), 120), cs = min(max(qx - 8, 0), 48);
    const float* bias = (const float*)(lds + NA_BIAS_OFF);
    const unsigned rowA = (unsigned)((wid >> 2) * 64 + seg * 16 + q), rowB = rowA + 128u;
    NaChain A, B;
    { const bf16_t* Qa = (const bf16_t*)(wsb + d.q_off) + rowA * DINP + 8 * g; A.qf[0] = *(const bf16x8*)Qa; A.qf[1] = *(const bf16x8*)(Qa + 32);
      const bf16_t* Qb = (const bf16_t*)(wsb + d.q_off) + rowB * DINP + 8 * g; B.qf[0] = *(const bf16x8*)Qb; B.qf[1] = *(const bf16x8*)(Qb + 32); }
#pragma unroll
    for (int c = 0; c < 4; ++c) { A.o[c] = (f32x4){0.f, 0.f, 0.f, 0.f}; B.o[c] = A.o[c]; }
    A.m = B.m = -1e30f; A.l = B.l = 0.f;
    const int sk = tid >> 3, sp8 = tid & 7;
    const unsigned srcoff = (unsigned)sk * (unsigned)(DINP * 2) + (unsigned)((sp8 ^ (sk & 7)) * 16);
    const int NT = 4 + d.nrows;
    LAS unsigned char* ldsl_ = (LAS unsigned char*)lds;
    const unsigned ldsw = (unsigned)wid * 1024u;
#define NA_TOK(t) (((t) < 4) ? d.ctx_base + 64 * (t) : d.row_base + 64 * ((t) - 4))
#define NA_DMA(t) do { const int tt_ = min((t), NT - 1); const unsigned to_ = (unsigned)NA_TOK(tt_) * (unsigned)(DINP * 2) + srcoff; const int sl_ = (t) & 3; \
        __builtin_amdgcn_global_load_lds((const unsigned*)(wsb + (d.k_off + to_)), (LAS unsigned*)(ldsl_ + NA_KOFF + sl_ * 8192 + ldsw), 16, 0, 0); \
        __builtin_amdgcn_global_load_lds((const unsigned*)(wsb + (d.v_off + to_)), (LAS unsigned*)(ldsl_ + NA_VOFF + sl_ * 8192 + ldsw), 16, 0, 0); } while (0)
    asm volatile("s_waitcnt vmcnt(0)" ::: "memory");
    NA_DMA(0); NA_DMA(1); NA_DMA(2);
    for (int t = 0; t < NT; ++t) {
        asm volatile("s_waitcnt vmcnt(4)" ::: "memory");
        __builtin_amdgcn_s_barrier();
        NA_DMA(t + 3);
        const int buf = t & 3; const char* Kt = lds + NA_KOFF + buf * 8192; const char* Vt = lds + NA_VOFF + buf * 8192;
        if (t < 4) { na_step<false, true, true>(A, B, Kt, Vt, 0, bias, bias, q, g, cs); na_step<false, true, true>(A, B, Kt, Vt, 32, bias, bias, q, g, cs); }
        else { const int R = d.R0 + (t - 4); const bool actA = (R >= rsA && R < rsA + 8), actB = (R >= rsB && R < rsB + 8);
            const float* brA = bias + (R - qyA + 7) * 64 + (31 - qx); const float* brB = bias + (R - qyB + 7) * 64 + (31 - qx);
            if (actA && actB) na_step<true, true, true>(A, B, Kt, Vt, cstart, brA, brB, q, g, cs);
            else if (actA) na_step<true, true, false>(A, B, Kt, Vt, cstart, brA, brB, q, g, cs);
            else if (actB) na_step<true, false, true>(A, B, Kt, Vt, cstart, brA, brB, q, g, cs); }
        asm volatile("s_waitcnt lgkmcnt(0)" ::: "memory");
    }
    asm volatile("s_waitcnt vmcnt(0)" ::: "memory");
    __builtin_amdgcn_s_barrier();
#define NA_EPI(C, ROW) do { float l_ = C.l; l_ += xchg16(l_); l_ += xchg32(l_); const float rl = __builtin_amdgcn_rcpf(l_); \
        bf16_t* Orow = (bf16_t*)(const_cast<unsigned char*>(wsb) + d.o_off) + (ROW) * 1024u + 4 * g; float s2 = 0.f; \
        _Pragma("unroll") for (int c = 0; c < 4; ++c) { const f32x4 v = C.o[c] * rl; s2 += (v[0] * v[0] + v[1] * v[1]) + (v[2] * v[2] + v[3] * v[3]); \
            u32x2 w; w.x = pk2(v[0], v[1]); w.y = pk2(v[2], v[3]); *(u32x2*)(Orow + 16 * c) = w; } \
        s2 += xchg16(s2); s2 += xchg32(s2); \
        if (g == 0) ((float*)(const_cast<unsigned char*>(wsb) + d.ss_off))[(ROW) * 16] = s2; } while (0)
    NA_EPI(A, rowA); NA_EPI(B, rowB);
    __syncthreads();
#undef NA_EPI
#undef NA_TOK
#undef NA_DMA
}

struct Params {
    const float* in[25];
    float* out;
    unsigned char* ws;
    int ph_lo, ph_hi;
};
enum { I_X = 0, I_C, I_CTX, I_CCTX, I_ADAW, I_ADAB, I_N1G, I_N2G, I_WIN, I_NABIAS, I_POOLW, I_POOLS, I_FNOW, I_QNORM, I_WUQ, I_KVNORM, I_WUK, I_WUV, I_GRPN, I_WOUT, I_ROUTER, I_EGATE, I_EUP, I_EDOWN, I_FINAL };
constexpr int NWAVES = 8, NTHR = 512;

__device__ __forceinline__ void tr_item(const float* src, long ld, bf16_t* dst, long dld, LAS float* scr, int lane, float wscale = 1.f) {
#pragma unroll 8
    for (int i = 0; i < 32; ++i) { const int kk = 2 * i + (lane >> 5); scr[kk * 33 + (lane & 31)] = src[(long)kk * ld + (lane & 31)] * wscale; }
    LDS_WAIT(); asm volatile("" ::: "memory");
    const int c = lane & 7;
#pragma unroll
    for (int j = 0; j < 4; ++j) { const int n = (lane >> 3) + 8 * j; const LAS float* s = scr + (8 * c) * 33 + n;
        u32x4 o; o.x = pk2(s[0 * 33], s[1 * 33]); o.y = pk2(s[2 * 33], s[3 * 33]); o.z = pk2(s[4 * 33], s[5 * 33]); o.w = pk2(s[6 * 33], s[7 * 33]);
        *(u32x4*)(dst + (long)n * dld + 8 * c) = o; }
    LDS_WAIT(); asm volatile("" ::: "memory");
}
constexpr int SMI_WIN = 16 * 53, SMI_WUQ = 4 * 12, SMI_WUK = 2 * 8, SMI_WUV = 2 * 8, SMI_POOL = 8, SMI_WOUT = 16 * 32;
constexpr int SMI_TOTAL = SMI_WIN + SMI_WUQ + SMI_WUK + SMI_WUV + SMI_POOL + SMI_WOUT;
__device__ __forceinline__ void small_weight_item(const Params& p, int l, int it, LAS float* scr, int lane) {
    unsigned char* sw = p.ws + WS_SMALLW + (size_t)l * SW_BYTES;
    int r = it;
    if (r < SMI_WIN) { const int kb = r / 53, nb = r % 53; tr_item(p.in[I_WIN] + (size_t)l * 1024 * DIN + (size_t)(64 * kb) * DIN + 32 * nb, DIN, (bf16_t*)(sw + SW_WIN) + (size_t)(32 * nb) * 1024 + 64 * kb, 1024, scr, lane, (32 * nb < 256) ? QSCALE_NA : 1.f); return; } r -= SMI_WIN;
    if (r < SMI_WUQ) { const int kb = r / 12, nb = r % 12; tr_item(p.in[I_WUQ] + (size_t)l * 256 * 384 + (size_t)(64 * kb) * 384 + 32 * nb, 384, (bf16_t*)(sw + SW_WUQ) + (size_t)(32 * nb) * 256 + 64 * kb, 256, scr, lane); return; } r -= SMI_WUQ;
    if (r < SMI_WUK) { const int kb = r / 8, nb = r % 8; tr_item(p.in[I_WUK] + (size_t)l * 128 * 256 + (size_t)(64 * kb) * 256 + 32 * nb, 256, (bf16_t*)(sw + SW_WUKV) + (size_t)(32 * nb) * 256 + 64 * kb, 256, scr, lane); return; } r -= SMI_WUK;
    if (r < SMI_WUV) { const int kb = r / 8, nb = r % 8; tr_item(p.in[I_WUV] + (size_t)l * 128 * 256 + (size_t)(64 * kb) * 256 + 32 * nb, 256, (bf16_t*)(sw + SW_WUKV) + (size_t)(256 + 32 * nb) * 256 + 64 * kb, 256, scr, lane); return; } r -= SMI_WUV;
    if (r < SMI_POOL) { const int g = r >> 1, nb = r & 1; tr_item(p.in[I_POOLW] + (size_t)l * 4 * 4096 + (size_t)g * 4096 + 32 * nb, 64, (bf16_t*)(sw + SW_POOL) + (size_t)(64 * g + 32 * nb) * 256 + 64 * g, 256, scr, lane); return; } r -= SMI_POOL;
    { const int kb = r / 32, nb = r % 32; tr_item(p.in[I_WOUT] + (size_t)l * 1024 * 1024 + (size_t)(64 * kb) * 1024 + 32 * nb, 1024, (bf16_t*)(sw + SW_WOUT) + (size_t)(32 * nb) * 1024 + 64 * kb, 1024, scr, lane); }
}
constexpr int EXI_PER_MAT = 16 * 32, EXI_TOTAL = NE * 3 * EXI_PER_MAT;
__device__ __forceinline__ void expert_weight_item(const Params& p, int l, int it, LAS float* scr, int lane) {
    const int e = it / (3 * EXI_PER_MAT), r0 = it % (3 * EXI_PER_MAT), which = r0 / EXI_PER_MAT, r = r0 % EXI_PER_MAT, kb = r / 32, nb = r % 32, n0 = 32 * nb;
    const size_t eoff = ((size_t)l * NE + e) * 1024 * 1024;
    if (which == 2) { tr_item(p.in[I_EDOWN] + eoff + (size_t)(64 * kb) * 1024 + n0, 1024, (bf16_t*)(p.ws + WS_WD) + (size_t)e * 1024 * 1024 + (size_t)n0 * 1024 + 64 * kb, 1024, scr, lane); return; }
    const float* src = (which == 0 ? p.in[I_EGATE] : p.in[I_EUP]) + eoff + (size_t)(64 * kb) * 1024 + n0;
    const int drow = (n0 >> 7) * 256 + (n0 & 127) + (which == 1 ? 128 : 0);
    tr_item(src, 1024, (bf16_t*)(p.ws + WS_WGU) + (size_t)e * 2048 * 1024 + (size_t)drow * 1024 + 64 * kb, 1024, scr, lane);
}
__device__ __forceinline__ void zero_region(unsigned char* base, int rows, int rowbytes, size_t pitch, int gtid, int GT) {
    const int per = rowbytes / 16; const long total = (long)rows * per;
    for (long i = gtid; i < total; i += GT) { const long r = i / per, c = i % per; *(u32x4*)(base + r * pitch + c * 16) = (u32x4){0u, 0u, 0u, 0u}; }
}

__device__ __forceinline__ void phase_a0(const Params& p, LAS unsigned char* ldsl) {
    const int tid = opaque_tid(), lane = tid & 63, wave = __builtin_amdgcn_readfirstlane(tid >> 6);
    const int G = gridDim.x, gtid = blockIdx.x * NTHR + tid, GT = G * NTHR, gw = blockIdx.x * NWAVES + wave, NGW = G * NWAVES;
    unsigned char* ws = p.ws;
    { float* rc = (float*)(ws + WS_ROPE); float* rs = rc + 1024;
      for (int i = gtid; i < 1024; i += GT) { const int pos = i >> 3, f = i & 7; const float inv = powf(10000.f, -(float)f / 8.f); const float ang = (float)pos * inv; rc[i] = cosf(ang); rs[i] = sinf(ang); }
      f32x2* tw = (f32x2*)(ws + WS_TW8192);
      for (int i = gtid; i < 8192; i += GT) { float s, c; sincospif(2.f * (float)i / 8192.f, &s, &c); tw[i] = (f32x2){c, s}; }
      f32x2* tw2 = (f32x2*)(ws + WS_TW256);
      for (int i = gtid; i < 256; i += GT) { float s, c; sincospif(2.f * (float)i / 256.f, &s, &c); tw2[i] = (f32x2){c, s}; }
      bf16_t* r128 = (bf16_t*)(ws + WS_R128);
      for (int i = gtid; i < 256 * 128; i += GT) { const int row = i >> 7, n1 = i & 127, w = row >> 5, ii = row & 31, k1 = 16 * w + (ii & 15), im = ii >> 4; const int idx = (k1 * n1) & 127;
          float s, c; sincospif(2.f * (float)idx / 128.f, &s, &c); r128[i] = f2bf(im ? -s : c); }
      bf16_t* r64 = (bf16_t*)(ws + WS_R64);
      for (int i = gtid; i < 128 * 128; i += GT) { const int row = i >> 7, kk = i & 127, rb = row >> 5, ii = row & 31, k2 = 16 * rb + (ii & 15), rio = ii >> 4, rii = kk >> 6, n2 = kk & 63; const int idx = (k2 * n2) & 63;
          float s, c; sincospif(2.f * (float)idx / 64.f, &s, &c);
          const float v = (rio == 0) ? (rii == 0 ? c : s) : (rii == 0 ? -s : c); r64[i] = f2bf(v); }
    }
    { LAS float* c64 = (LAS float*)ldsl; LAS float* s64 = c64 + 64;
      if (tid < 64) { float s, c; sincospif(2.f * (float)tid / 64.f, &s, &c); c64[tid] = c; s64[tid] = s; }
      __syncthreads();
      for (int i = gtid; i < 2 * 512 * 256; i += GT) { const int l = i >> 17, kk = (i >> 8) & 511, j = i & 255, ri = kk >> 8, gc = kk & 255, g = gc >> 6, c = gc & 63;
          const float* fw = p.in[I_FNOW] + (size_t)l * 65536 + (size_t)(g * 64) * 256 + j; float a = 0.f;
          for (int m = 0; m < 64; ++m) { const int idx = (c * m) & 63; a += (ri ? s64[idx] : c64[idx]) * fw[(size_t)m * 256]; }
          ((bf16_t*)(ws + WS_SMALLW + (size_t)l * SW_BYTES + SW_WF))[kk * 256 + j] = f2bf(a); }
      __syncthreads();
    }
    for (int l = 0; l < 2; ++l) { unsigned char* sw = ws + WS_SMALLW + (size_t)l * SW_BYTES;
        zero_region(sw + SW_WIN + (size_t)DIN * 1024 * 2, DINP - DIN, 2048, 2048, gtid, GT);
        zero_region(sw + SW_WUQ + (size_t)384 * 256 * 2, 128, 512, 512, gtid, GT);
        zero_region(sw + SW_WUKV + 256, 512, 256, 512, gtid, GT);
        for (int g = 0; g < 4; ++g) for (int g2 = 0; g2 < 4; ++g2) if (g != g2) zero_region(sw + SW_POOL + (size_t)(64 * g) * 512 + 128 * g2, 64, 128, 512, gtid, GT); }
    { LAS float* sv = (LAS float*)(ldsl + 1024); LAS float* red = sv + 5 * 1024;
      for (int i = tid; i < 5 * 1024; i += NTHR) { const int v = i >> 10, k = i & 1023; const float x = (v < 4) ? p.in[I_C][v * 1024 + k] : p.in[I_CCTX][k]; sv[i] = x / (1.f + expf(-x)); }
      __syncthreads();
      float* mods = (float*)(ws + WS_MODS);
      for (int item = blockIdx.x; item < 192; item += G) { const int l = item / 96, j0 = (item % 96) * 64, col = tid & 63, kg = tid >> 6;
          const float* w = p.in[I_ADAW] + (size_t)l * 1024 * 6144 + (size_t)(kg * 128) * 6144 + j0 + col;
          float a0 = 0.f, a1 = 0.f, a2 = 0.f, a3 = 0.f, a4 = 0.f;
#pragma unroll 4
          for (int k = 0; k < 128; ++k) { const float wv = w[(size_t)k * 6144]; const int kk = kg * 128 + k;
              a0 += sv[kk] * wv; a1 += sv[1024 + kk] * wv; a2 += sv[2048 + kk] * wv; a3 += sv[3072 + kk] * wv; a4 += sv[4096 + kk] * wv; }
          red[(kg * 5 + 0) * 64 + col] = a0; red[(kg * 5 + 1) * 64 + col] = a1; red[(kg * 5 + 2) * 64 + col] = a2; red[(kg * 5 + 3) * 64 + col] = a3; red[(kg * 5 + 4) * 64 + col] = a4;
          __syncthreads();
          if (tid < 320) { const int v = tid >> 6; float s = 0.f;
#pragma unroll
              for (int q = 0; q < 8; ++q) s += red[(q * 5 + v) * 64 + col];
              mods[(size_t)(l * 5 + v) * 6144 + j0 + col] = s + p.in[I_ADAB][l * 6144 + j0 + col]; }
          __syncthreads(); }
    }
    { LAS float* scr = (LAS float*)(ldsl + 32768 + wave * 8448);
      for (int it = gw; it < 2 * SMI_TOTAL + EXI_TOTAL; it += NGW) {
          if (it < SMI_TOTAL) small_weight_item(p, 0, it, scr, lane);
          else if (it < 2 * SMI_TOTAL) small_weight_item(p, 1, it - SMI_TOTAL, scr, lane);
          else expert_weight_item(p, 0, it - 2 * SMI_TOTAL, scr, lane); } }
}

__device__ __forceinline__ void mod_row_store(const f32x4 (&v)[4], float rstd, const float* g, const float* shift, const float* scale, bf16_t* hrow, int lane) {
#pragma unroll
    for (int j = 0; j < 4; ++j) { const int c = 4 * lane + 256 * j; const f32x4 gg = *(const f32x4*)(g + c), sh = *(const f32x4*)(shift + c), sc = *(const f32x4*)(scale + c);
        const f32x4 h = v[j] * rstd * gg * (sc + 1.f) + sh;
        u32x2 w; w.x = pk2(h[0], h[1]); w.y = pk2(h[2], h[3]); *(u32x2*)(hrow + c) = w; }
}
__device__ __forceinline__ float row_rstd(const f32x4 (&v)[4]) {
    float s = 0.f;
#pragma unroll
    for (int j = 0; j < 4; ++j) s += (v[j][0] * v[j][0] + v[j][1] * v[j][1]) + (v[j][2] * v[j][2] + v[j][3] * v[j][3]);
    return rsqrtf(wave_sum(s) * (1.f / 1024.f) + EPS);
}
__device__ __forceinline__ void load_row_bf16(f32x4 (&v)[4], const bf16_t* r, int lane) {
#pragma unroll
    for (int j = 0; j < 4; ++j) { const u32x2 w = *(const u32x2*)(r + 4 * lane + 256 * j); v[j] = (f32x4){bflo(w.x), bfhi(w.x), bflo(w.y), bfhi(w.y)}; }
}
__device__ __forceinline__ void load_row_f32(f32x4 (&v)[4], const float* r, int lane) {
#pragma unroll
    for (int j = 0; j < 4; ++j) v[j] = *(const f32x4*)(r + 4 * lane + 256 * j);
}
__device__ __forceinline__ void load_res_row(f32x4 (&v)[4], int tok, const bf16_t* xlb, const float* xc, int lane) {
    if (tok < TL) load_row_bf16(v, xlb + (size_t)tok * 1024, lane); else load_row_f32(v, xc + (size_t)(tok - TL) * 1024, lane);
}
struct ModCoef { f32x4 ca[4], cb[4]; };
__device__ __forceinline__ void load_modcoef(ModCoef& m, const float* g, const float* shift, const float* scale, int lane) {
#pragma unroll
    for (int j = 0; j < 4; ++j) { const int c = 4 * lane + 256 * j; m.ca[j] = *(const f32x4*)(g + c) * (*(const f32x4*)(scale + c) + 1.f); m.cb[j] = *(const f32x4*)(shift + c); }
}
__device__ __forceinline__ void mod_row_store2(const f32x4 (&v)[4], float rstd, const ModCoef& m, bf16_t* hrow, int lane) {
#pragma unroll
    for (int j = 0; j < 4; ++j) { const f32x4 h = v[j] * rstd * m.ca[j] + m.cb[j]; u32x2 w; w.x = pk2(h[0], h[1]); w.y = pk2(h[2], h[3]); *(u32x2*)(hrow + 4 * lane + 256 * j) = w; }
}
__device__ __forceinline__ void phase_a1(const Params& p) {
    const int tid_ = opaque_tid(); const int lane = tid_ & 63, gw = blockIdx.x * NWAVES + (tid_ >> 6), NGW = gridDim.x * NWAVES;
    const float* mods = (const float*)(p.ws + WS_MODS); bf16_t* H = (bf16_t*)(p.ws + WS_H);
    ModCoef mc; int curb = -1;
    int tok = gw; f32x4 v[4];
    if (tok < TA) { const float* xr = (tok < TL) ? p.in[I_X] + (size_t)tok * 1024 : p.in[I_CTX] + (size_t)(tok - TL) * 1024;
#pragma unroll
        for (int j = 0; j < 4; ++j) v[j] = *(const f32x4*)(xr + 4 * lane + 256 * j); }
    while (tok < TA) {
        const int ntk = tok + NGW; f32x4 vn[4];
        if (ntk < TA) { const float* xr = (ntk < TL) ? p.in[I_X] + (size_t)ntk * 1024 : p.in[I_CTX] + (size_t)(ntk - TL) * 1024;
#pragma unroll
            for (int j = 0; j < 4; ++j) vn[j] = *(const f32x4*)(xr + 4 * lane + 256 * j); }
        const int bidx = (tok < TL) ? (tok >> 13) : 4;
        if (bidx != curb) { const float* mb = mods + (size_t)bidx * 6144; load_modcoef(mc, p.in[I_N1G], mb, mb + 1024, lane); curb = bidx; }
        const float rstd = row_rstd(v);
        mod_row_store2(v, rstd, mc, H + (size_t)tok * 1024, lane);
#pragma unroll
        for (int j = 0; j < 4; ++j) v[j] = vn[j];
        tok = ntk;
    }
}
__device__ __forceinline__ void prep_token(const Params& p, int l, int tok, int lane) {
    const bf16_t* P = (const bf16_t*)(p.ws + WS_P); const bf16_t* prow = P + (size_t)tok * DINP;
    int t, nn; if (tok < TL) { t = tok & (SEQ - 1); nn = SEQ; } else { t = (tok - TL) & (CTXL - 1); nn = CTXL; }
    const int g = lane >> 4, w = 2 << g, hw = w >> 1;
    const int lo = max(t - hw, 0), hi = min(t + w - hw, nn); const bf16_t* pb = P + (size_t)(tok - t) * DINP + PC_PL + 4 * lane;
    const u32x2 wq = *(const u32x2*)(prow + PC_QC + 4 * lane);
    const unsigned wkv = *(const unsigned*)(prow + PC_KVC + 2 * lane);
    const bf16_t wkr = prow[PC_KR + (lane & 31)];
    const u32x2 own = *(const u32x2*)(pb + (size_t)t * DINP);
    u32x2 xw[16];
#pragma unroll
    for (int j = 0; j < 16; ++j) xw[j] = *(const u32x2*)(pb + (size_t)min(lo + j, hi - 1) * DINP);
    const int dd = lane & 31, pos = (tok < TL) ? ((dd >> 4) ? (t & 63) : (t >> 6)) : 0, f = dd & 7;
    const float rc = ((const float*)(p.ws + WS_ROPE))[pos * 8 + f], rsn = ((const float*)(p.ws + WS_ROPE))[1024 + pos * 8 + f];
    const f32x4 gq = *(const f32x4*)(p.in[I_QNORM] + l * 256 + 4 * lane);
    const f32x2 gkv = *(const f32x2*)(p.in[I_KVNORM] + l * 128 + 2 * lane);
    { const float a0 = bflo(wq.x), a1 = bfhi(wq.x), a2 = bflo(wq.y), a3 = bfhi(wq.y);
      const float rstd = rsqrtf(wave_sum((a0 * a0 + a1 * a1) + (a2 * a2 + a3 * a3)) * (1.f / 256.f) + EPS);
      u32x2 o; o.x = pk2(a0 * rstd * gq[0], a1 * rstd * gq[1]); o.y = pk2(a2 * rstd * gq[2], a3 * rstd * gq[3]);
      *(u32x2*)((bf16_t*)(p.ws + WS_QCN) + (size_t)tok * 256 + 4 * lane) = o; }
    { const float a0 = bflo(wkv), a1 = bfhi(wkv);
      const float rstd = rsqrtf(wave_sum(a0 * a0 + a1 * a1) * (1.f / 128.f) + EPS);
      unsigned* ck = (unsigned*)((bf16_t*)(p.ws + WS_CKV) + (size_t)tok * 256);
      ck[lane] = pk2(a0 * rstd * gkv[0], a1 * rstd * gkv[1]); ck[64 + lane] = 0u; }
    { const float val = bf2f(wkr); const float par = __shfl_xor(val, 8); float o = val;
      if (tok < TL) o = ((dd >> 3) & 1) ? (par * rsn + val * rc) : (val * rc - par * rsn);
      if (lane < 32) ((bf16_t*)(p.ws + WS_KR))[(size_t)tok * 32 + lane] = f2bf(o); }
    { float s0 = 0.f, s1 = 0.f, s2 = 0.f, s3 = 0.f;
#pragma unroll
      for (int j = 0; j < 16; ++j) { const float m = (lo + j < hi) ? 1.f : 0.f; s0 += m * bflo(xw[j].x); s1 += m * bfhi(xw[j].x); s2 += m * bflo(xw[j].y); s3 += m * bfhi(xw[j].y); }
      const float inv = 1.f / (float)(hi - lo);
      u32x2 o; o.x = pk2(s0 * inv - bflo(own.x), s1 * inv - bfhi(own.x)); o.y = pk2(s2 * inv - bflo(own.y), s3 * inv - bfhi(own.y));
      *(u32x2*)((bf16_t*)(p.ws + WS_POOLA) + (size_t)tok * 256 + 4 * lane) = o; }
}
__device__ __forceinline__ void fft1_ctx_item(const Params& p, int item, int lane) {
    const int b = item >> 8, k1 = (item >> 6) & 3, n2 = item & 63;
    const bf16_t* P = (const bf16_t*)(p.ws + WS_P);
    float yr[4] = {0.f, 0.f, 0.f, 0.f}, yi[4] = {0.f, 0.f, 0.f, 0.f};
#pragma unroll
    for (int n1 = 0; n1 < 4; ++n1) { const u32x2 x = *(const u32x2*)(P + (size_t)(TL + b * 256 + 64 * n1 + n2) * DINP + PC_FL + 4 * lane);
        const int q = (n1 * k1) & 3; const float cq = (q == 0) ? 1.f : (q == 2 ? -1.f : 0.f), sq = (q == 1) ? 1.f : (q == 3 ? -1.f : 0.f);
        const float u0 = bflo(x.x), u1 = bfhi(x.x), u2 = bflo(x.y), u3 = bfhi(x.y);
        yr[0] += u0 * cq; yr[1] += u1 * cq; yr[2] += u2 * cq; yr[3] += u3 * cq; yi[0] -= u0 * sq; yi[1] -= u1 * sq; yi[2] -= u2 * sq; yi[3] -= u3 * sq; }
    const f32x2 tw = ((const f32x2*)(p.ws + WS_TW256))[(n2 * k1) & 255]; const float tr = tw.x, ti = -tw.y;
    bf16_t* yp = (bf16_t*)(p.ws + WS_YP) + YP_CTX_OFF + ((size_t)(b * 4 + k1) * 128 + n2) * 256 + 4 * lane;
    u32x2 o; o.x = pk2(yr[0] * tr - yi[0] * ti, yr[1] * tr - yi[1] * ti); o.y = pk2(yr[2] * tr - yi[2] * ti, yr[3] * tr - yi[3] * ti); *(u32x2*)yp = o;
    o.x = pk2(yr[0] * ti + yi[0] * tr, yr[1] * ti + yi[1] * tr); o.y = pk2(yr[2] * ti + yi[2] * tr, yr[3] * ti + yi[3] * tr); *(u32x2*)(yp + 64 * 256) = o;
}
__device__ __forceinline__ void fft1_item(const Params& p, int b, int n2, char* lds) {
    const int tid = opaque_tid(), wid = tid >> 6, lane = tid & 63, r32 = lane & 31, hi = lane >> 5;
    const bf16_t* P = (const bf16_t*)(p.ws + WS_P); bf16_t* YP = (bf16_t*)(p.ws + WS_YP);
    const bf16_t* R128 = (const bf16_t*)(p.ws + WS_R128); const f32x2* TW = (const f32x2*)(p.ws + WS_TW8192);
#pragma unroll
    for (int kt = 0; kt < 2; ++kt)
#pragma unroll
        for (int ct = 0; ct < 2; ++ct) stage_vtile(lds + (kt * 2 + ct) * 16384, P + (size_t)(b * SEQ + 4096 * kt + n2) * DINP + PC_FL + 128 * ct, (long)64 * DINP);
    __syncthreads();
    for (int ct = 0; ct < 2; ++ct) {
        f32x16 od[4]; od[0] = f32x16{}; od[1] = f32x16{}; od[2] = f32x16{}; od[3] = f32x16{};
#pragma unroll
        for (int kt = 0; kt < 2; ++kt) {
            const bf16_t* ar = R128 + (size_t)(32 * wid + r32) * 128 + 64 * kt + 8 * hi;
            const bf16x8 pa0 = *(const bf16x8*)(ar), pa1 = *(const bf16x8*)(ar + 16), pa2 = *(const bf16x8*)(ar + 32), pa3 = *(const bf16x8*)(ar + 48);
            const int vb = (int)(uintptr_t)(lds + (kt * 2 + ct) * 16384) + v_rd_base(lane);
            pv_one<0>(od[0], vb, pa0, pa1, pa2, pa3); pv_one<1>(od[1], vb, pa0, pa1, pa2, pa3); pv_one<2>(od[2], vb, pa0, pa1, pa2, pa3); pv_one<3>(od[3], vb, pa0, pa1, pa2, pa3);
        }
#pragma unroll
        for (int r = 0; r < 8; ++r) { const int k1 = 16 * wid + crow(r, hi); const f32x2 tw = TW[(n2 * k1) & 8191]; const float tr = tw.x, ti = -tw.y;
            bf16_t* yp = YP + ((size_t)(b * 128 + k1) * 128 + n2) * 256 + 128 * ct + r32;
#pragma unroll
            for (int d0 = 0; d0 < 4; ++d0) { const float yr = od[d0][r], yi = od[d0][r + 8];
                yp[32 * d0] = f2bf(yr * tr - yi * ti); yp[64 * 256 + 32 * d0] = f2bf(yr * ti + yi * tr); } }
    }
    __syncthreads();
}
constexpr int ZP = 520;
__device__ __forceinline__ void fft2_item(const bf16_t* yblk, int tok0, int tokstride, float norm, const bf16_t* R64, const bf16_t* WF, bf16_t* CAT, float* SSG, char* lds) {
    const int tid = opaque_tid(), wid = tid >> 6, lane = tid & 63, r32 = lane & 31, hi = lane >> 5;
    bf16_t* Z = (bf16_t*)(lds + 65536);
#pragma unroll
    for (int kt = 0; kt < 2; ++kt)
#pragma unroll
        for (int ct = 0; ct < 2; ++ct) stage_vtile(lds + (kt * 2 + ct) * 16384, yblk + (size_t)(64 * kt) * 256 + 128 * ct, 256);
    __syncthreads();
    { const int rb = wid & 3, ct = wid >> 2;
      f32x16 od[4]; od[0] = f32x16{}; od[1] = f32x16{}; od[2] = f32x16{}; od[3] = f32x16{};
#pragma unroll
      for (int kt = 0; kt < 2; ++kt) {
          const bf16_t* ar = R64 + (size_t)(32 * rb + r32) * 128 + 64 * kt + 8 * hi;
          const bf16x8 pa0 = *(const bf16x8*)(ar), pa1 = *(const bf16x8*)(ar + 16), pa2 = *(const bf16x8*)(ar + 32), pa3 = *(const bf16x8*)(ar + 48);
          const int vb = (int)(uintptr_t)(lds + (kt * 2 + ct) * 16384) + v_rd_base(lane);
          pv_one<0>(od[0], vb, pa0, pa1, pa2, pa3); pv_one<1>(od[1], vb, pa0, pa1, pa2, pa3); pv_one<2>(od[2], vb, pa0, pa1, pa2, pa3); pv_one<3>(od[3], vb, pa0, pa1, pa2, pa3);
      }
#pragma unroll
      for (int r = 0; r < 8; ++r) { bf16_t* zr = Z + (size_t)(16 * rb + crow(r, hi)) * ZP + 128 * ct + r32;
#pragma unroll
          for (int d0 = 0; d0 < 4; ++d0) { zr[32 * d0] = f2bf(od[d0][r]); zr[256 + 32 * d0] = f2bf(od[d0][r + 8]); } }
    }
    __syncthreads();
    { const int rb2 = wid & 1, cb = wid >> 1, ct2 = cb >> 1, d0a = 2 * (cb & 1);
      f32x16 o2[2]; o2[0] = f32x16{}; o2[1] = f32x16{};
      const int sr = tid >> 4, sc = (tid & 15) * 8;
      bf16x8 wq[4][4];
#define WF_LOAD(t) do { const bf16_t* s_ = WF + (size_t)(64 * (t) + sr) * 256 + sc; wq[(t) & 3][0] = *(const bf16x8*)s_; wq[(t) & 3][1] = *(const bf16x8*)(s_ + 32 * 256); \
                        wq[(t) & 3][2] = *(const bf16x8*)(s_ + 128); wq[(t) & 3][3] = *(const bf16x8*)(s_ + 32 * 256 + 128); } while (0)
#define WF_WRITE(t) do { char* nb_ = lds + ((t) & 1) * 32768; *(bf16x8*)(nb_ + v_st(sr, sc)) = wq[(t) & 3][0]; *(bf16x8*)(nb_ + v_st(32 + sr, sc)) = wq[(t) & 3][1]; \
                         *(bf16x8*)(nb_ + 16384 + v_st(sr, sc)) = wq[(t) & 3][2]; *(bf16x8*)(nb_ + 16384 + v_st(32 + sr, sc)) = wq[(t) & 3][3]; } while (0)
      WF_LOAD(0); WF_LOAD(1); WF_LOAD(2); WF_LOAD(3);
      WF_WRITE(0);
      __syncthreads();
#pragma unroll
      for (int kt = 0; kt < 8; ++kt) {
          if (kt + 1 < 8) WF_WRITE(kt + 1);
          if (kt + 4 < 8) WF_LOAD(kt + 4);
          const bf16_t* ar = Z + (size_t)(32 * rb2 + r32) * ZP + 64 * kt + 8 * hi;
          const bf16x8 pa0 = *(const bf16x8*)(ar), pa1 = *(const bf16x8*)(ar + 16), pa2 = *(const bf16x8*)(ar + 32), pa3 = *(const bf16x8*)(ar + 48);
          const int vb = (int)(uintptr_t)(lds + (kt & 1) * 32768 + ct2 * 16384) + v_rd_base(lane) + d0a * 512;
          pv_one<0>(o2[0], vb, pa0, pa1, pa2, pa3); pv_one<1>(o2[1], vb, pa0, pa1, pa2, pa3);
          __syncthreads();
      }
#undef WF_LOAD
#undef WF_WRITE
#pragma unroll
      for (int r = 0; r < 16; ++r) { const int k2 = 32 * rb2 + crow(r, hi); const size_t tok = (size_t)tok0 + (size_t)tokstride * k2;
          const float v0 = o2[0][r] * norm, v1 = o2[1][r] * norm;
          bf16_t* cp = CAT + tok * 1024 + CC_C + 64 * cb + r32; cp[0] = f2bf(v0); cp[32] = f2bf(v1);
          float s2 = v0 * v0 + v1 * v1;
          s2 += __shfl_xor(s2, 1); s2 += __shfl_xor(s2, 2); s2 += __shfl_xor(s2, 4); s2 += __shfl_xor(s2, 8); s2 += __shfl_xor(s2, 16);
          if (r32 == 0) SSG[tok * 16 + 8 + cb] = s2; }
    }
    __syncthreads();
}

__device__ __forceinline__ void phase_mergenorm(const Params& p, int l, int ntok, bf16_t* OUT) {
    const int tid_ = opaque_tid(); const int lane = tid_ & 63, gw = blockIdx.x * NWAVES + (tid_ >> 6), NGW = gridDim.x * NWAVES;
    bf16_t* CAT = (bf16_t*)(p.ws + WS_CAT); const float* SSG = (const float*)(p.ws + WS_SSG); const float* gn = p.in[I_GRPN] + l * 1024;
    f32x4 gv[2][2];
#pragma unroll
    for (int j = 0; j < 2; ++j) { gv[j][0] = *(const f32x4*)(gn + 8 * lane + 512 * j); gv[j][1] = *(const f32x4*)(gn + 8 * lane + 512 * j + 4); }
    int tok = gw; f32x4 ss; u32x4 w[2];
#define SSG_LOAD(t) ({ const float* q_ = SSG + (size_t)(t) * 16; const f32x4 a_ = *(const f32x4*)q_, b_ = *(const f32x4*)(q_ + 4), c_ = *(const f32x4*)(q_ + 8), d_ = *(const f32x4*)(q_ + 12); \
        (f32x4){(a_[0] + a_[1]) + (a_[2] + a_[3]), (b_[0] + b_[1]) + (b_[2] + b_[3]), (c_[0] + c_[1]) + (c_[2] + c_[3]), (d_[0] + d_[1]) + (d_[2] + d_[3])}; })
    if (tok < ntok) { ss = SSG_LOAD(tok); w[0] = *(const u32x4*)(CAT + (size_t)tok * 1024 + 8 * lane); w[1] = *(const u32x4*)(CAT + (size_t)tok * 1024 + 512 + 8 * lane); }
    while (tok < ntok) {
        const int ntk = tok + NGW; f32x4 ssn; u32x4 wn[2];
        if (ntk < ntok) { ssn = SSG_LOAD(ntk); wn[0] = *(const u32x4*)(CAT + (size_t)ntk * 1024 + 8 * lane); wn[1] = *(const u32x4*)(CAT + (size_t)ntk * 1024 + 512 + 8 * lane); }
#pragma unroll
        for (int j = 0; j < 2; ++j) { const int c = 8 * lane + 512 * j, g = c >> 8; const float rstd = rsqrtf(ss[g] * (1.f / 256.f) + EPS);
            u32x4 x = w[j]; const f32x4 g0 = gv[j][0], g1 = gv[j][1];
            x.x = pk2(bflo(x.x) * rstd * g0[0], bfhi(x.x) * rstd * g0[1]); x.y = pk2(bflo(x.y) * rstd * g0[2], bfhi(x.y) * rstd * g0[3]);
            x.z = pk2(bflo(x.z) * rstd * g1[0], bfhi(x.z) * rstd * g1[1]); x.w = pk2(bflo(x.w) * rstd * g1[2], bfhi(x.w) * rstd * g1[3]);
            *(u32x4*)(OUT + (size_t)tok * 1024 + c) = x; }
        ss = ssn; w[0] = wn[0]; w[1] = wn[1]; tok = ntk;
    }
}
__device__ __forceinline__ void phase_router(const Params& p, int l, int ntok, const bf16_t* xl, const float* xc, LAS unsigned char* ldsl) {
    const int tid = opaque_tid(), lane = tid & 63, gw = blockIdx.x * NWAVES + (tid >> 6), NGW = gridDim.x * NWAVES;
    LAS float* rw = (LAS float*)ldsl;
    for (int i = tid; i < 1024 * 16; i += NTHR) { const int k = i >> 4, e = i & 15; rw[k * 20 + ((((e >> 2) + (k >> 4)) & 3) << 2) + (e & 3)] = p.in[I_ROUTER][(size_t)l * 1024 * 16 + i]; }
    __syncthreads();
    const float* mods = (const float*)(p.ws + WS_MODS) + (size_t)l * 5 * 6144; bf16_t* H = (bf16_t*)(p.ws + WS_H); float* aff = (float*)(p.ws + WS_AFF);
    const float* g2 = p.in[I_N2G] + l * 1024;
    const int rot = (lane >> 2) & 3;
    const int eidx = ((lane >> 5) & 1) * 8 + ((lane >> 4) & 1) * 4 + ((lane >> 3) & 1) * 2 + ((lane >> 2) & 1);
    ModCoef mc; int curb = -1;
    int tok = gw; f32x4 v[4];
    if (tok < ntok) load_res_row(v, tok, xl, xc, lane);
    while (tok < ntok) {
        const int ntk = tok + NGW; f32x4 vn[4];
        if (ntk < ntok) load_res_row(vn, ntk, xl, xc, lane);
        const int bidx = (tok < TL) ? (tok >> 13) : 4;
        if (bidx != curb) { const float* mb = mods + (size_t)bidx * 6144; load_modcoef(mc, g2, mb + 3072, mb + 4096, lane); curb = bidx; }
        const float rstd = row_rstd(v);
        float acc[16];
#pragma unroll
        for (int e = 0; e < 16; ++e) acc[e] = 0.f;
#pragma unroll
        for (int j = 0; j < 4; ++j) { v[j] = v[j] * rstd * mc.ca[j] + mc.cb[j];
            u32x2 w; w.x = pk2(v[j][0], v[j][1]); w.y = pk2(v[j][2], v[j][3]); *(u32x2*)(H + (size_t)tok * 1024 + 4 * lane + 256 * j) = w; }
#define RW_LOAD(W, g) do { _Pragma("unroll") for (int ii = 0; ii < 2; ++ii) { const LAS float* wr_ = rw + (4 * lane + 256 * ((g) >> 1) + 2 * ((g) & 1) + ii) * 20; \
            _Pragma("unroll") for (int q = 0; q < 4; ++q) W[ii * 4 + q] = *(const LAS f32x4*)(wr_ + (((q + rot) & 3) << 2)); } } while (0)
#define RW_FMA(W, g) do { _Pragma("unroll") for (int ii = 0; ii < 2; ++ii) { const float hv = v[(g) >> 1][2 * ((g) & 1) + ii]; \
            _Pragma("unroll") for (int q = 0; q < 4; ++q) { const f32x4 ww = W[ii * 4 + q]; acc[4 * q + 0] += hv * ww[0]; acc[4 * q + 1] += hv * ww[1]; acc[4 * q + 2] += hv * ww[2]; acc[4 * q + 3] += hv * ww[3]; } } } while (0)
        { f32x4 wA[8], wB[8];
          RW_LOAD(wA, 0);
          RW_LOAD(wB, 1); asm volatile("" ::: "memory"); RW_FMA(wA, 0); asm volatile("" ::: "memory");
          RW_LOAD(wA, 2); asm volatile("" ::: "memory"); RW_FMA(wB, 1); asm volatile("" ::: "memory");
          RW_LOAD(wB, 3); asm volatile("" ::: "memory"); RW_FMA(wA, 2); asm volatile("" ::: "memory");
          RW_LOAD(wA, 4); asm volatile("" ::: "memory"); RW_FMA(wB, 3); asm volatile("" ::: "memory");
          RW_LOAD(wB, 5); asm volatile("" ::: "memory"); RW_FMA(wA, 4); asm volatile("" ::: "memory");
          RW_LOAD(wA, 6); asm volatile("" ::: "memory"); RW_FMA(wB, 5); asm volatile("" ::: "memory");
          RW_LOAD(wB, 7); asm volatile("" ::: "memory"); RW_FMA(wA, 6); asm volatile("" ::: "memory");
          RW_FMA(wB, 7); }
#undef RW_LOAD
#undef RW_FMA
        float t8[8], t4[4], t2[2], lg;
#pragma unroll
        for (int i = 0; i < 8; ++i) { const bool up = (lane & 32) != 0; const float snd = up ? acc[i] : acc[i + 8]; const float rcv = xchg32(snd); t8[i] = (up ? acc[i + 8] : acc[i]) + rcv; }
#pragma unroll
        for (int i = 0; i < 4; ++i) { const bool up = (lane & 16) != 0; const float snd = up ? t8[i] : t8[i + 4]; const float rcv = __shfl_xor(snd, 16); t4[i] = (up ? t8[i + 4] : t8[i]) + rcv; }
#pragma unroll
        for (int i = 0; i < 2; ++i) { const bool up = (lane & 8) != 0; const float snd = up ? t4[i] : t4[i + 2]; const float rcv = xchg8(snd); t2[i] = (up ? t4[i + 2] : t4[i]) + rcv; }
        { const bool up = (lane & 4) != 0; const float snd = up ? t2[0] : t2[1]; const float rcv = __shfl_xor(snd, 4); lg = (up ? t2[1] : t2[0]) + rcv; }
        lg += xchg2(lg); lg += xchg1(lg);
        float mx = lg;
        mx = fmaxf(mx, __shfl_xor(mx, 4)); mx = fmaxf(mx, xchg8(mx)); mx = fmaxf(mx, __shfl_xor(mx, 16)); mx = fmaxf(mx, xchg32(mx));
        const float ex = expf(lg - mx); float sum = ex;
        sum += __shfl_xor(sum, 4); sum += xchg8(sum); sum += __shfl_xor(sum, 16); sum += xchg32(sum);
        if ((lane & 3) == 0) aff[(size_t)tok * 16 + eidx] = ex / sum;
#pragma unroll
        for (int j = 0; j < 4; ++j) v[j] = vn[j];
        tok = ntk;
    }
    __syncthreads();
}
__device__ __forceinline__ unsigned block_exscan(unsigned x, LAS unsigned* wtot, int lane, int wid) {
    unsigned v = x;
#pragma unroll
    for (int o = 1; o < 64; o <<= 1) { const unsigned y = __shfl_up(v, o); if (lane >= o) v += y; }
    if (lane == 63) wtot[wid] = v;
    __syncthreads();
    unsigned base = 0;
    for (int w = 0; w < wid; ++w) base += wtot[w];
    __syncthreads();
    return base + v - x;
}
__device__ __forceinline__ void topk_item(const Params& p, int tokbase, int n, int e, int K, int slotbase, LAS unsigned char* ldsl) {
    const int tid = opaque_tid(), lane = tid & 63, wid = tid >> 6;
    LAS unsigned* keys = (LAS unsigned*)ldsl; LAS unsigned* hist = keys + 8192; LAS unsigned* wtot = hist + 256; LAS unsigned* misc = wtot + 16;
    const float* aff = (const float*)(p.ws + WS_AFF); int* seltok = (int*)(p.ws + WS_SELTOK); float* selgate = (float*)(p.ws + WS_SELGATE); int* slotof = (int*)(p.ws + WS_SLOTOF) + e;
    const int nact = (n >= NTHR) ? NTHR : n, chunk = n / nact;
    for (int t = tid; t < n; t += NTHR) keys[t] = __float_as_uint(aff[(size_t)(tokbase + t) * 16 + e]);
    if (tid == 0) { unsigned z_ = 0u, k_ = (unsigned)K; asm volatile("" : "+v"(z_), "+v"(k_)); misc[0] = z_; misc[1] = k_; }
    __syncthreads();
    for (int ps = 3; ps >= 0; --ps) {
        if (tid < 256) hist[tid] = 0u;
        __syncthreads();
        const unsigned prefix = misc[0]; const unsigned mask = (ps == 3) ? 0u : (0xFFFFFFFFu << (8 * (ps + 1)));
        if (tid < nact) for (int i = 0; i < chunk; ++i) { const unsigned key = keys[tid * chunk + i]; if (((key ^ prefix) & mask) == 0u) __hip_atomic_fetch_add(&hist[(key >> (8 * ps)) & 255u], 1u, __ATOMIC_RELAXED, __HIP_MEMORY_SCOPE_WORKGROUP); }
        __syncthreads();
        if (wid == 0) { const unsigned need = misc[1];
            unsigned hq[4];
#pragma unroll
            for (int j = 0; j < 4; ++j) hq[j] = hist[255 - 4 * lane - j];
            const unsigned tot = hq[0] + hq[1] + hq[2] + hq[3]; unsigned inc = tot;
#pragma unroll
            for (int o = 1; o < 64; o <<= 1) { const unsigned y = __shfl_up(inc, o); if (lane >= o) inc += y; }
            const unsigned exc = inc - tot;
            if (exc < need && inc >= need) { unsigned cum = exc; int j = 0;
                for (; j < 3; ++j) { if (cum + hq[j] >= need) break; cum += hq[j]; }
                misc[0] = prefix | ((unsigned)(255 - 4 * lane - j) << (8 * ps)); misc[1] = need - cum; } }
        __syncthreads();
    }
    const unsigned T = misc[0], need = misc[1];
    unsigned cgt = 0u, ceq = 0u;
    if (tid < nact) for (int i = 0; i < chunk; ++i) { const unsigned key = keys[tid * chunk + i]; cgt += (key > T) ? 1u : 0u; ceq += (key == T) ? 1u : 0u; }
    const unsigned eqb = block_exscan(ceq, wtot, lane, wid);
    const unsigned teq = (eqb >= need) ? 0u : min(need - eqb, ceq);
    unsigned pos = block_exscan(cgt + teq, wtot, lane, wid);
    if (tid < nact) { unsigned es = 0u;
        for (int i = 0; i < chunk; ++i) { const int t = tid * chunk + i; const unsigned key = keys[t]; bool take = key > T;
            if (key == T) { take = (eqb + es) < need; ++es; }
            if (take) { const int slot = slotbase + (int)pos; ++pos; seltok[slot] = tokbase + t; selgate[slot] = __uint_as_float(key); slotof[(size_t)(tokbase + t) * 16] = slot; }
            else slotof[(size_t)(tokbase + t) * 16] = -1; } }
    __syncthreads();
}
__device__ __forceinline__ void phase_gather(const Params& p, int nslot) {
    const int tid_ = opaque_tid(); const int lane = tid_ & 63, gw = blockIdx.x * NWAVES + (tid_ >> 6), NGW = gridDim.x * NWAVES;
    const bf16_t* H = (const bf16_t*)(p.ws + WS_H); bf16_t* XS = (bf16_t*)(p.ws + WS_XS); const int* seltok = (const int*)(p.ws + WS_SELTOK);
    for (int s0 = gw * 4; s0 < nslot; s0 += NGW * 4) {
        int tk[4]; u32x4 a[4], b[4];
#pragma unroll
        for (int i = 0; i < 4; ++i) tk[i] = seltok[s0 + i];
#pragma unroll
        for (int i = 0; i < 4; ++i) { a[i] = *(const u32x4*)(H + (size_t)tk[i] * 1024 + 8 * lane); b[i] = *(const u32x4*)(H + (size_t)tk[i] * 1024 + 512 + 8 * lane); }
#pragma unroll
        for (int i = 0; i < 4; ++i) { *(u32x4*)(XS + (size_t)(s0 + i) * 1024 + 8 * lane) = a[i]; *(u32x4*)(XS + (size_t)(s0 + i) * 1024 + 512 + 8 * lane) = b[i]; }
    }
}
__device__ __forceinline__ void phase_combine(const Params& p, int l, int ntok, const bf16_t* xl, const float* xc, bf16_t* xlo, float* xco, float* fin, bf16_t* H) {
    const int tid_ = opaque_tid(); const int lane = tid_ & 63, gw = blockIdx.x * NWAVES + (tid_ >> 6), NGW = gridDim.x * NWAVES;
    const float* modsl = (const float*)(p.ws + WS_MODS) + (size_t)l * 5 * 6144; const float* modsn = modsl + 5 * 6144;
    const bf16_t* YB = (const bf16_t*)(p.ws + WS_YB); const int* slotof = (const int*)(p.ws + WS_SLOTOF);
    const bool last = (l == 1);
    ModCoef mc; f32x4 gt[4]; int curb = -1;
#define FIRST_PAIR(SL, S0, S1, W0, W1, MR) do { unsigned long long m_ = __ballot((SL) >= 0); S0 = 0; S1 = 0; W0 = 0.f; W1 = 0.f; \
        if (m_) { S0 = __builtin_amdgcn_readlane(SL, __builtin_ctzll(m_)); m_ &= m_ - 1; W0 = 1.f; S1 = S0; } \
        if (m_) { S1 = __builtin_amdgcn_readlane(SL, __builtin_ctzll(m_)); m_ &= m_ - 1; W1 = 1.f; } MR = m_; } while (0)
#define LOAD_PAIR(Q0, Q1, S0, S1) do { const bf16_t* y0_ = YB + (size_t)(S0) * 1024 + 4 * lane; const bf16_t* y1_ = YB + (size_t)(S1) * 1024 + 4 * lane; \
        _Pragma("unroll") for (int j = 0; j < 4; ++j) { Q0[j] = *(const u32x2*)(y0_ + 256 * j); Q1[j] = *(const u32x2*)(y1_ + 256 * j); } } while (0)
    int tok = gw; f32x4 v[4]; int sl = -1, sl1 = -1;
    u32x2 q0[4], q1[4]; int s0 = 0, s1 = 0; float w0 = 0.f, w1 = 0.f; unsigned long long mrest = 0;
    if (tok < ntok) { load_res_row(v, tok, xl, xc, lane); sl = (lane < 16) ? slotof[(size_t)tok * 16 + lane] : -1; }
    if (tok + NGW < ntok) sl1 = (lane < 16) ? slotof[(size_t)(tok + NGW) * 16 + lane] : -1;
    FIRST_PAIR(sl, s0, s1, w0, w1, mrest);
    LOAD_PAIR(q0, q1, s0, s1);
    while (tok < ntok) {
        const int ntk = tok + NGW, ntk2 = ntk + NGW; f32x4 vn[4]; int sl2 = -1;
        if (ntk < ntok) load_res_row(vn, ntk, xl, xc, lane);
        if (ntk2 < ntok) sl2 = (lane < 16) ? slotof[(size_t)ntk2 * 16 + lane] : -1;
        u32x2 q0n[4], q1n[4]; int s0n, s1n; float w0n, w1n; unsigned long long mrestn;
        FIRST_PAIR(sl1, s0n, s1n, w0n, w1n, mrestn);
        LOAD_PAIR(q0n, q1n, s0n, s1n);
        const int bidx = (tok < TL) ? (tok >> 13) : 4;
        f32x4 a[4];
#pragma unroll
        for (int j = 0; j < 4; ++j) { a[j][0] = w0 * bflo(q0[j].x); a[j][1] = w0 * bfhi(q0[j].x); a[j][2] = w0 * bflo(q0[j].y); a[j][3] = w0 * bfhi(q0[j].y);
            a[j][0] += w1 * bflo(q1[j].x); a[j][1] += w1 * bfhi(q1[j].x); a[j][2] += w1 * bflo(q1[j].y); a[j][3] += w1 * bfhi(q1[j].y); }
        unsigned long long m = mrest;
        while (m) {
            const int e0 = __builtin_ctzll(m); m &= m - 1; const int t0 = __builtin_amdgcn_readlane(sl, e0);
            int t1 = t0; float u1 = 0.f;
            if (m) { const int e1 = __builtin_ctzll(m); m &= m - 1; t1 = __builtin_amdgcn_readlane(sl, e1); u1 = 1.f; }
            u32x2 r0[4], r1[4];
            LOAD_PAIR(r0, r1, t0, t1);
#pragma unroll
            for (int j = 0; j < 4; ++j) { a[j][0] += bflo(r0[j].x); a[j][1] += bfhi(r0[j].x); a[j][2] += bflo(r0[j].y); a[j][3] += bfhi(r0[j].y);
                a[j][0] += u1 * bflo(r1[j].x); a[j][1] += u1 * bfhi(r1[j].x); a[j][2] += u1 * bflo(r1[j].y); a[j][3] += u1 * bfhi(r1[j].y); }
        }
        if (bidx != curb) { curb = bidx;
#pragma unroll
            for (int j = 0; j < 4; ++j) gt[j] = *(const f32x4*)(modsl + (size_t)bidx * 6144 + 5120 + 4 * lane + 256 * j);
            if (last) {
#pragma unroll
                for (int j = 0; j < 4; ++j) mc.ca[j] = *(const f32x4*)(p.in[I_FINAL] + 4 * lane + 256 * j);
            } else { const float* mb = modsn + (size_t)bidx * 6144; load_modcoef(mc, p.in[I_N1G] + 1024, mb, mb + 1024, lane); } }
#pragma unroll
        for (int j = 0; j < 4; ++j) v[j] = v[j] + gt[j] * a[j];
        const float rstd = row_rstd(v);
        if (last) {
#pragma unroll
            for (int j = 0; j < 4; ++j) *(f32x4*)(fin + (size_t)tok * 1024 + 4 * lane + 256 * j) = v[j] * rstd * mc.ca[j];
        } else {
            if (tok < TL) {
#pragma unroll
                for (int j = 0; j < 4; ++j) { u32x2 w; w.x = pk2(v[j][0], v[j][1]); w.y = pk2(v[j][2], v[j][3]); *(u32x2*)(xlo + (size_t)tok * 1024 + 4 * lane + 256 * j) = w; }
            } else {
#pragma unroll
                for (int j = 0; j < 4; ++j) *(f32x4*)(xco + (size_t)(tok - TL) * 1024 + 4 * lane + 256 * j) = v[j];
            }
            mod_row_store2(v, rstd, mc, H + (size_t)tok * 1024, lane);
        }
#pragma unroll
        for (int j = 0; j < 4; ++j) { v[j] = vn[j]; q0[j] = q0n[j]; q1[j] = q1n[j]; }
        sl = sl1; sl1 = sl2; tok = ntk; w0 = w0n; w1 = w1n; mrest = mrestn;
    }
#undef FIRST_PAIR
#undef LOAD_PAIR
}

constexpr int N_PHASES = 26;
__global__ void __launch_bounds__(NTHR, 2) hybrid_fwd(Params p) {
    unsigned char* const lds = g_lds;
    LAS unsigned char* ldsl = (LAS unsigned char*)g_lds;
    volatile LAS unsigned* MISC = (volatile LAS unsigned*)(ldsl + MISC_OFF);
    const int G = gridDim.x, bx = blockIdx.x, NGW = G * NWAVES, GT = G * NTHR;
#define TIDS() const int tid = opaque_tid(), lane = tid & 63, wave = __builtin_amdgcn_readfirstlane(tid >> 6), gw = bx * NWAVES + wave, gtid = bx * NTHR + tid; (void)lane; (void)gw; (void)gtid
    { TIDS(); for (int u = tid; u < (LDS_BYTES - LDSCTL_OFF) / 4; u += NTHR) ((LAS unsigned*)(ldsl + LDSCTL_OFF))[u] = 0u; }
    __syncthreads();
    unsigned char* ws = p.ws;
    const int lo = p.ph_lo, hi = p.ph_hi;
#if MK_ONE_LAUNCH
    XcdBarrier bar = xcd_barrier_post((unsigned*)(ws + WS_CTL) + 4096, MISC + 8);
    bool first_sync = true;
#define SEAM(k) do { if (lo <= (k) && (k) + 1 < hi) { if (first_sync) { asm volatile("s_waitcnt vmcnt(0)" ::: "memory"); __threadfence(); cg::this_grid().sync(); __threadfence(); first_sync = false; } else xcd_barrier(bar); } } while (0)
#else
#define SEAM(k) do { } while (0)
#endif
#ifndef DBG_PHASE
#define DBG_PHASE -1
#endif
#ifndef DBG_PHMASK
#define DBG_PHMASK 0
#endif
#define PH_EN(t) ((DBG_PHASE < 0 && DBG_PHMASK == 0) || DBG_PHASE == (t) || ((t) < 32 && ((DBG_PHMASK >> (t)) & 1)))
#ifndef DBG_SUBD
#define DBG_SUBD -1
#endif
#define SUBD_EN(t) (DBG_SUBD < 0 || DBG_SUBD == (t))
#define IN(k) (lo <= (k) && (k) < hi)
#ifndef DBG_REP
#define DBG_REP 0
#endif
#define NREP(bit) (1 + ((DBG_REP >> (bit)) & 1))
    bf16_t* xl = (bf16_t*)(ws + WS_XLB); float* xc = (float*)(ws + WS_XC);
    bf16_t* H = (bf16_t*)(ws + WS_H); bf16_t* P = (bf16_t*)(ws + WS_P); bf16_t* CAT = (bf16_t*)(ws + WS_CAT); float* SSG = (float*)(ws + WS_SSG);

    if (IN(0) && PH_EN(100)) { for (int rep = 0; rep < NREP(12); ++rep) phase_a0(p, ldsl); SEAM(0); }
    if (IN(1) && PH_EN(101)) { for (int rep = 0; rep < NREP(13); ++rep) phase_a1(p); SEAM(1); }
#if MK_ONE_LAUNCH
    if ((DBG_REP >> 14) & 1) for (int xb = 0; xb < 20; ++xb) xcd_barrier(bar);
#endif
    for (int l = 0; l < 2; ++l) {
        const int pb = 2 + 12 * l; const bool wctx = (l == 0);
        unsigned char* sw = ws + WS_SMALLW + (size_t)l * SW_BYTES;
        const float* modsl = (const float*)(ws + WS_MODS) + (size_t)l * 5 * 6144;
        if (IN(pb + 0) && PH_EN(0)) {
            pg8::Gemm g{H, 1024, (const bf16_t*)(sw + SW_WIN), 1024}; pg8::Order S; S.init(TA / 256, DINP / 256, G, bx, 256L * 1024, 256L * 1024);
            pg8::EpiStore E{P, DINP, P, DINP, 1 << 30};
            for (int rep = 0; rep < NREP(0); ++rep) pg8::gemm_phase(ldsl, g, S, E);
            SEAM(pb + 0);
        }
        if (IN(pb + 1) && PH_EN(1)) {
            TIDS();
            for (int rep = 0; rep < NREP(11); ++rep) {
            for (int it = bx; it < NBATCH * 64; it += G) fft1_item(p, it >> 6, it & 63, (char*)lds);
            for (int tok = gw; tok < TA; tok += NGW) prep_token(p, l, tok, lane);
            if (wctx) for (int it = gw; it < NBATCH * 4 * 64; it += NGW) fft1_ctx_item(p, it, lane);
            }
            SEAM(pb + 1);
        }
        if (IN(pb + 2) && PH_EN(2)) {
            for (int rep = 0; rep < NREP(1); ++rep) { float* SSGr = rep ? (float*)(ws + WS_SSGD) : SSG;
              pg8::Gemm g{(const bf16_t*)(ws + WS_QCN), 256, (const bf16_t*)(sw + SW_WUQ), 256}; pg8::Order S; S.init(TA / 256, 5, G, bx, 256L * 256, 256L * 256); S.d_mode = 1;
              pg8::EpiD E{pg8::EpiQ{(bf16_t*)(ws + WS_QD), (const float*)(ws + WS_ROPE), (const float*)(ws + WS_ROPE) + 1024},
                          pg8::EpiStore{(bf16_t*)(ws + WS_KNOPE), 256, (bf16_t*)(ws + WS_VD), 256, 1},
                          pg8::EpiPool{CAT, p.in[I_POOLS] + l * 256, SSGr}};
              pg8::gemm_phase(ldsl, g, S, E);
            }
            SEAM(pb + 2);
        }
        if (IN(pb + 3) && PH_EN(3)) {
#ifndef DBG_SUB
#define DBG_SUB -1
#endif
#define SUB_EN(t) (DBG_SUB < 0 || DBG_SUB == (t))
#pragma unroll 1
            for (int es = 0; es < 3; ++es) {
            const int which = (bx & 1) ? (es + 1) % 3 : es;
            if (which == 0) {
            for (int rep = 0; rep < NREP(2); ++rep)
            if (SUB_EN(0)) for (int u = bx; u < (wctx ? 272 : 256); u += G) {
                AttnDesc d; int b, h, tok0;
                if (u < 256) { const int xcd = u & 7, j = u >> 3, bh = xcd * 2 + (j >> 4), qb = j & 15; b = bh >> 2; h = bh & 3; tok0 = b * SEQ + qb * 512;
                    d.first_base = b * SEQ; d.n_first = 128; d.second_base = TL + b * CTXL; d.clampmax = 1 << 20; d.NT = 132; d.nrows = 512; }
                else { b = (u - 256) >> 2; h = u & 3; tok0 = TL + b * CTXL; d.first_base = tok0; d.n_first = 4; d.second_base = tok0; d.clampmax = 0; d.NT = 4; d.nrows = 256; }
                d.q_off = (unsigned)(WS_QD + ((size_t)tok0 * 384 + h * 96) * 2); d.ka_off = (unsigned)(WS_KNOPE + (size_t)h * 64 * 2); d.kb_off = (unsigned)WS_KR; d.v_off = (unsigned)(WS_VD + (size_t)h * 64 * 2);
                d.o_off = (unsigned)(WS_CAT + ((size_t)tok0 * 1024 + CC_D + h * 64) * 2); d.ss_off = (unsigned)((rep ? WS_SSGD : WS_SSG) + ((size_t)tok0 * 16 + 12 + h) * 4); d.qy0 = 0; d.R0 = 0;
                mla_unit(d, ws, (char*)lds); }
            }
            if (which == 1) {
            for (int rep = 0; rep < NREP(3); ++rep)
            if (SUB_EN(1)) for (int u = bx; u < 512 + G; u += G) {
                if (u >= 512) { u = 512 + (u - 512 + G - 16) % G; if (!wctx || u >= 528) break; }
                TIDS(); NaDesc d; int b, h, tok0;
                if (u < 512) { b = u >> 7; h = (u >> 5) & 3; const int r4 = u & 31; tok0 = b * SEQ + r4 * 256;
                    d.qy0 = 4 * r4; d.R0 = min(max(4 * r4 - 4, 0), 120); d.nrows = min(max(4 * r4 - 1, 0), 120) + 8 - d.R0; d.row_base = b * SEQ + d.R0 * 64; }
                else { const int uc = u - 512; b = uc >> 2; h = uc & 3; tok0 = TL + b * CTXL; d.qy0 = 0; d.R0 = 0; d.nrows = 0; d.row_base = 0; }
                d.ctx_base = TL + b * CTXL;
                float* bt = (float*)((char*)lds + NA_BIAS_OFF);
                for (int i = tid; i < 15 * 64; i += NTHR) { const int dc = (i & 63) - 16; bt[i] = (dc >= 0 && dc < 31) ? p.in[I_NABIAS][((size_t)(l * 4 + h) * 15 + (i >> 6)) * 31 + dc] * 1.4426950408889634f : 0.f; }
                __syncthreads();
                d.q_off = (unsigned)(WS_P + ((size_t)tok0 * DINP + PC_AQ + h * 64) * 2); d.k_off = (unsigned)(WS_P + (size_t)(PC_AK + h * 64) * 2); d.v_off = (unsigned)(WS_P + (size_t)(PC_AV + h * 64) * 2);
                d.o_off = (unsigned)(WS_CAT + ((size_t)tok0 * 1024 + CC_A + h * 64) * 2); d.ss_off = (unsigned)((rep ? WS_SSGD : WS_SSG) + ((size_t)tok0 * 16 + 0 + h) * 4);
                na_unit(d, ws, (char*)lds); }
            }
            if (which == 2) {
            for (int rep = 0; rep < NREP(4); ++rep)
            if (SUB_EN(2)) for (int it = bx; it < 512 + G; it += G) {
                if (it >= 512) { it = 512 + (it - 512 + G - 48) % G; if (!wctx || it >= 528) break; }
                const bf16_t* yb; int tok0, tstr; float nrm;
                if (it < 512) { yb = (const bf16_t*)(ws + WS_YP) + (size_t)it * 128 * 256; tok0 = (it >> 7) * SEQ + (it & 127); tstr = 128; nrm = 1.f / sqrtf(8192.f * 64.f); }
                else { const int ic = it - 512; yb = (const bf16_t*)(ws + WS_YP) + YP_CTX_OFF + (size_t)ic * 128 * 256; tok0 = TL + (ic >> 2) * CTXL + (ic & 3); tstr = 4; nrm = 1.f / sqrtf(256.f * 64.f); }
                fft2_item(yb, tok0, tstr, nrm, (const bf16_t*)(ws + WS_R64), (const bf16_t*)(sw + SW_WF), CAT, rep ? (float*)(ws + WS_SSGD) : SSG, (char*)lds); }
            }
            }
            SEAM(pb + 3);
        }
        if (IN(pb + 4) && PH_EN(4)) { if (NREP(15) > 1) phase_mergenorm(p, l, wctx ? TA : TL, (bf16_t*)(ws + WS_R1)); phase_mergenorm(p, l, wctx ? TA : TL, CAT); SEAM(pb + 4); }
        if (IN(pb + 5) && PH_EN(5)) {
            pg8::Gemm g{CAT, 1024, (const bf16_t*)(sw + SW_WOUT), 1024}; pg8::Order S; S.init((wctx ? TA : TL) / 256, 4, G, bx, 256L * 1024, 256L * 1024);
            pg8::EpiRes E{(l == 0) ? p.in[I_X] : (const float*)nullptr, xl, (l == 0) ? p.in[I_CTX] : (const float*)xc, xl, xc, modsl};
            for (int rep = 0; rep < ((l == 0) ? NREP(5) : 1); ++rep) pg8::gemm_phase(ldsl, g, S, E);
            SEAM(pb + 5);
        }
        if (IN(pb + 6) && PH_EN(6)) { for (int rep = 0; rep < NREP(6); ++rep) phase_router(p, l, wctx ? TA : TL, xl, xc, ldsl); SEAM(pb + 6); }
        if (IN(pb + 7) && PH_EN(7)) {
            TIDS(); const int nitems = wctx ? 128 : 64;
            for (int rep = 0; rep < NREP(7); ++rep)
            for (int it = bx; it < nitems; it += G) {
                if (it < 64) { const int b = it >> 4, e = it & 15; topk_item(p, b * SEQ, SEQ, e, CAPL, (e * NBATCH + b) * CAPL, ldsl); }
                else { const int b = (it - 64) >> 4, e = it & 15; topk_item(p, TL + b * CTXL, CTXL, e, CAPC, NSLOT_L + e * 256 + b * CAPC, ldsl);
                    if (b == 0 && tid < 128) { ((int*)(ws + WS_SELTOK))[NSLOT_L + e * 256 + 128 + tid] = 0; ((float*)(ws + WS_SELGATE))[NSLOT_L + e * 256 + 128 + tid] = 0.f; } }
            }
            SEAM(pb + 7);
        }
        if (IN(pb + 9) && PH_EN(9)) {
            pg8::Gemm g{(const bf16_t*)H, 1024, (const bf16_t*)(ws + WS_WGU), 1024}; pg8::Order S; S.init((wctx ? NSLOT : NSLOT_L) / 256, 8, G, bx, 256L * 1024, 256L * 1024);
            S.e_div = 16; S.e_mul = 2048L * 1024; S.pm_ctx0 = 256;
            pg8::EpiSwiGLU E{(bf16_t*)(ws + WS_HID)};
            for (int rep = 0; rep < NREP(9); ++rep) pg8::gemm_phase<pg8::EpiSwiGLU, true>(ldsl, g, S, E, (const int*)(ws + WS_SELTOK));
            SEAM(pb + 9);
        }
        if (IN(pb + 10) && PH_EN(10)) {
            pg8::Gemm g{(const bf16_t*)(ws + WS_HID), 1024, (const bf16_t*)(ws + WS_WD), 1024}; pg8::Order S; S.init((wctx ? NSLOT : NSLOT_L) / 256, 4, G, bx, 256L * 1024, 256L * 1024);
            S.e_div = 16; S.e_mul = 1024L * 1024; S.pm_ctx0 = 256;
            pg8::EpiGate E{(bf16_t*)(ws + WS_YB), (const float*)(ws + WS_SELGATE)};
            for (int rep = 0; rep < NREP(10); ++rep) pg8::gemm_phase(ldsl, g, S, E);
            SEAM(pb + 10);
        }
        if (IN(pb + 11) && PH_EN(11)) {
            if (NREP(16) > 1) phase_combine(p, l, wctx ? TA : TL, xl, xc, (bf16_t*)(ws + WS_R2), (float*)(ws + WS_R2) + (size_t)TL * 512, (float*)(ws + WS_R2), (bf16_t*)(ws + WS_R2) + (size_t)TA * 2048);
            phase_combine(p, l, wctx ? TA : TL, xl, xc, xl, xc, p.out, H);
            if (l == 0) { TIDS(); LAS float* scr = (LAS float*)(ldsl + wave * 8448); for (int it = gw; it < EXI_TOTAL; it += NGW) expert_weight_item(p, 1, it, scr, lane); }
            SEAM(pb + 11);
        }
    }
}

extern "C" void kernel_launch(void* const* d_in, const int* in_sizes, int n_in, void* d_out, int out_size, void* d_ws, size_t ws_size, hipStream_t stream) {
    static int grid = 0;
    if (grid == 0) {
        if (n_in != 25 || out_size != TL * DM || ws_size < WS_END) { fprintf(stderr, "kernel_launch: unexpected shapes: n_in %d out %d ws %zu (need %zu)\n", n_in, out_size, ws_size, (size_t)WS_END); grid = -1; return; }
        int dev = 0, cus = 0, per_cu = 0;
        if (hipGetDevice(&dev) != hipSuccess || hipDeviceGetAttribute(&cus, hipDeviceAttributeMultiprocessorCount, dev) != hipSuccess) { grid = -1; return; }
        if (hipFuncSetAttribute((const void*)hybrid_fwd, hipFuncAttributeMaxDynamicSharedMemorySize, LDS_BYTES) != hipSuccess) { fprintf(stderr, "kernel_launch: hipFuncSetAttribute failed\n"); grid = -1; return; }
        if (hipOccupancyMaxActiveBlocksPerMultiprocessor(&per_cu, (const void*)hybrid_fwd, NTHR, LDS_BYTES) != hipSuccess || per_cu < 1) { fprintf(stderr, "kernel_launch: occupancy query says %d\n", per_cu); }
        (void)hipGetLastError();
        grid = cus;
    }
    if (grid < 0) return;
    (void)hipMemsetAsync((char*)d_ws + WS_CTL, 0, CTL_BYTES, stream);
    Params a{};
    for (int i = 0; i < 25; ++i) a.in[i] = (const float*)d_in[i];
    a.out = (float*)d_out; a.ws = (unsigned char*)d_ws;
#if MK_ONE_LAUNCH
    a.ph_lo = 0; a.ph_hi = N_PHASES;
    void* args[] = {&a};
    hipError_t e = hipLaunchCooperativeKernel((const void*)hybrid_fwd, dim3(grid), dim3(NTHR), args, LDS_BYTES, stream);
    if (e != hipSuccess) fprintf(stderr, "kernel_launch: cooperative launch failed: %s (grid %d)\n", hipGetErrorString(e), grid);
#else
    for (int ph = 0; ph < N_PHASES; ++ph) { a.ph_lo = ph; a.ph_hi = ph + 1; hipLaunchKernelGGL(hybrid_fwd, dim3(grid), dim3(NTHR), LDS_BYTES, stream, a); }
    const hipError_t le = hipPeekAtLastError();
    if (le != hipSuccess) fprintf(stderr, "kernel_launch: launch failed: %s\n", hipGetErrorName(le));
#endif
}
```

```cpp
#include <hip/hip_runtime.h>
#include <hip/hip_cooperative_groups.h>
#include <cstdio>
#include <cstdint>
#include <cmath>
namespace cg = cooperative_groups;

#ifndef MK_ONE_LAUNCH
#define MK_ONE_LAUNCH 1
#endif

#define GAS __attribute__((address_space(1)))
#define LAS __attribute__((address_space(3)))
typedef unsigned short bf16_t;
typedef short bf16x8 __attribute__((ext_vector_type(8)));
typedef short s16x4 __attribute__((ext_vector_type(4)));
typedef float f32x2 __attribute__((ext_vector_type(2)));
typedef float f32x4 __attribute__((ext_vector_type(4)));
typedef float f32x16 __attribute__((ext_vector_type(16)));
typedef unsigned u32x2 __attribute__((ext_vector_type(2)));
typedef unsigned u32x4 __attribute__((ext_vector_type(4)));
typedef __bf16 bf16x2_t __attribute__((ext_vector_type(2)));

constexpr int NBATCH = 4, SEQ = 8192, DM = 1024, CTXL = 256;
constexpr int TL = NBATCH * SEQ, TC = NBATCH * CTXL, TA = TL + TC;
constexpr int DIN = 1696, DINP = 1792;
constexpr int NE = 16, CAPL = 1024, CAPC = 32;
constexpr int NSLOT_L = NBATCH * NE * CAPL;
constexpr int NSLOT = NSLOT_L + NE * 256;
constexpr float EPS = 1e-6f;
constexpr float QSCALE_NA = 0.125f * 1.4426950408889634f, QSCALE_MLA = 0.10206207261596575f * 1.4426950408889634f;
constexpr int PC_AQ = 0, PC_AK = 256, PC_AV = 512, PC_PL = 768, PC_FL = 1024, PC_QC = 1280, PC_KVC = 1536, PC_KR = 1664;
constexpr int CC_A = 0, CC_B = 256, CC_C = 512, CC_D = 768;

constexpr size_t al256(size_t x) { return (x + 255) / 256 * 256; }
constexpr size_t WS_CTL = 0, CTL_BYTES = 1u << 20;
constexpr size_t WS_MODS = WS_CTL + CTL_BYTES;
constexpr size_t WS_ROPE = WS_MODS + al256(2 * 5 * 6144 * 4);
constexpr size_t WS_TW8192 = WS_ROPE + 8192;
constexpr size_t WS_TW256 = WS_TW8192 + 65536;
constexpr size_t WS_R128 = WS_TW256 + 2048;
constexpr size_t WS_R64 = WS_R128 + 65536;
constexpr size_t WS_AFF = WS_R64 + 32768;
constexpr size_t WS_SLOTOF = WS_AFF + al256((size_t)TA * 16 * 4);
constexpr size_t WS_SELTOK = WS_SLOTOF + al256((size_t)TA * 16 * 4);
constexpr size_t WS_SELGATE = WS_SELTOK + al256((size_t)NSLOT * 4);
constexpr size_t WS_SSG = WS_SELGATE + al256((size_t)NSLOT * 4);
constexpr size_t WS_SMALLW = WS_SSG + al256((size_t)TA * 16 * 4);
constexpr size_t SW_WIN = 0;
constexpr size_t SW_WUQ = SW_WIN + (size_t)DINP * 1024 * 2;
constexpr size_t SW_WUKV = SW_WUQ + 512 * 256 * 2;
constexpr size_t SW_POOL = SW_WUKV + 512 * 256 * 2;
constexpr size_t SW_WF = SW_POOL + 256 * 256 * 2;
constexpr size_t SW_WOUT = SW_WF + 512 * 256 * 2;
constexpr size_t SW_BYTES = SW_WOUT + 1024 * 1024 * 2;
constexpr size_t WS_WGU = WS_SMALLW + 2 * SW_BYTES;
constexpr size_t WS_WD = WS_WGU + (size_t)NE * 2048 * 1024 * 2;
constexpr size_t WS_H = WS_WD + (size_t)NE * 1024 * 1024 * 2;
constexpr size_t WS_XC = WS_H + (size_t)TA * 1024 * 2;
constexpr size_t WS_R1 = WS_XC + (size_t)TC * 1024 * 4;
constexpr size_t WS_P = WS_R1;
constexpr size_t WS_QCN = WS_P + (size_t)TA * DINP * 2;
constexpr size_t WS_CKV = WS_QCN + (size_t)TA * 256 * 2;
constexpr size_t WS_POOLA = WS_CKV + (size_t)TA * 256 * 2;
constexpr size_t WS_KR = WS_POOLA + (size_t)TA * 256 * 2;
constexpr size_t WS_R1_END = WS_KR + (size_t)TA * 32 * 2;
constexpr size_t WS_XS = WS_R1;
constexpr size_t WS_YB = WS_R1;
constexpr size_t WS_R2 = WS_R1_END;
constexpr size_t WS_QD = WS_R2;
constexpr size_t WS_KNOPE = WS_QD + (size_t)TA * 384 * 2;
constexpr size_t WS_VD = WS_KNOPE + (size_t)TA * 256 * 2;
constexpr size_t WS_YP = WS_VD + (size_t)TA * 256 * 2;
constexpr size_t YP_CTX_OFF = (size_t)4 * 128 * 128 * 256;
constexpr size_t WS_CAT = WS_YP + (YP_CTX_OFF + (size_t)4 * 4 * 128 * 256) * 2;
constexpr size_t WS_R2_END = WS_CAT + (size_t)TA * 1024 * 2;
constexpr size_t WS_HID = WS_R2;
constexpr size_t WS_XLB = WS_R2_END;
constexpr size_t WS_SSGD = WS_XLB + (size_t)TL * 1024 * 2;
constexpr size_t WS_END = WS_SSGD + al256((size_t)TA * 16 * 4);
static_assert(WS_R1_END - WS_R1 >= (size_t)NSLOT * 1024 * 2, "XS/YB overlay fits R1");
static_assert(WS_R2_END - WS_R2 >= (size_t)NSLOT * 1024 * 2, "HID overlay fits R2");

constexpr int RING_BYTES = 131072;
constexpr int LDSCTL_OFF = RING_BYTES + 8192, MISC_OFF = LDSCTL_OFF + 320;
constexpr int LDS_BYTES = 147456;
constexpr int PTAB_OFF = LDSCTL_OFF + 1024;
extern __shared__ __attribute__((aligned(16))) unsigned char g_lds[];
__device__ __forceinline__ unsigned long long ptab_get(int i) {
    const LAS unsigned* t = (const LAS unsigned*)((LAS unsigned char*)g_lds + PTAB_OFF);
    const unsigned lo = __builtin_amdgcn_readfirstlane(t[2 * i]), hi = __builtin_amdgcn_readfirstlane(t[2 * i + 1]);
    return ((unsigned long long)hi << 32) | lo;
}
__device__ __forceinline__ const float* in_ptr(int i) { return (const float*)ptab_get(i); }
__device__ __forceinline__ float* out_ptr() { return (float*)ptab_get(25); }
__device__ __forceinline__ unsigned char* ws_ptr() { return (unsigned char*)ptab_get(26); }

#define RLX_AGENT __ATOMIC_RELAXED, __HIP_MEMORY_SCOPE_AGENT
#define LDS_WAIT() asm volatile("s_waitcnt lgkmcnt(0)" ::: "memory")
#define SBAR() __builtin_amdgcn_sched_barrier(0)
__device__ __forceinline__ int opaque_tid() { int x = threadIdx.x; asm volatile("" : "+v"(x)); return x; }
__device__ __forceinline__ unsigned pk2(float lo, float hi) { f32x2 v = {lo, hi}; bf16x2_t b = __builtin_convertvector(v, bf16x2_t); return __builtin_bit_cast(unsigned, b); }
__device__ __forceinline__ bf16_t f2bf(float f) { return (bf16_t)(pk2(f, 0.f) & 0xffffu); }
__device__ __forceinline__ float bf2f(unsigned x) { return __uint_as_float(x << 16); }
__device__ __forceinline__ float bflo(unsigned w) { return __uint_as_float(w << 16); }
__device__ __forceinline__ float bfhi(unsigned w) { return __uint_as_float(w & 0xffff0000u); }
template <int CTRL> __device__ __forceinline__ float dpp_mov(float v) { return __builtin_bit_cast(float, __builtin_amdgcn_update_dpp(0, __builtin_bit_cast(int, v), CTRL, 0xF, 0xF, true)); }
__device__ __forceinline__ float wave_sum(float v) {
    v += dpp_mov<0xB1>(v); v += dpp_mov<0x4E>(v); v += dpp_mov<0x141>(v); v += dpp_mov<0x140>(v);
    v += __shfl_xor(v, 16);
    { auto rr = __builtin_amdgcn_permlane32_swap(__float_as_uint(v), __float_as_uint(v), false, false); v = __uint_as_float(rr[0]) + __uint_as_float(rr[1]); }
    return v;
}
__device__ __forceinline__ float xchg32(float v) { auto rr = __builtin_amdgcn_permlane32_swap(__float_as_uint(v), __float_as_uint(v), false, false); return (threadIdx.x & 32) ? __uint_as_float(rr[0]) : __uint_as_float(rr[1]); }
__device__ __forceinline__ float xchg16(float v) { auto rr = __builtin_amdgcn_permlane16_swap(__float_as_uint(v), __float_as_uint(v), false, false); return (threadIdx.x & 16) ? __uint_as_float(rr[0]) : __uint_as_float(rr[1]); }
__device__ __forceinline__ float xchg8(float v) { return dpp_mov<0x128>(v); }
__device__ __forceinline__ float xchg2(float v) { return dpp_mov<0x4E>(v); }
__device__ __forceinline__ float xchg1(float v) { return dpp_mov<0xB1>(v); }
__device__ __forceinline__ float silu_f(float x) { return x / (1.f + __expf(-x)); }

#define XB_TMO      128
#define XB_XCNT(j)  (256  + 64 * (j))
#define XB_XSUB(j)  (1280 + 64 * (j))
#define XB_XGEN(j)  (2304 + 64 * (j))
#define XB_TOP      3328
#define XB_TOPGEN   3392
#define XCD_BAR_WORDS 3456
#define XB_SPIN_CAP (1u << 22)
__device__ __forceinline__ unsigned xb_ld(unsigned* p)              { return __hip_atomic_load(p, __ATOMIC_RELAXED, __HIP_MEMORY_SCOPE_AGENT); }
__device__ __forceinline__ unsigned xb_add(unsigned* p, unsigned v) { return __hip_atomic_fetch_add(p, v, __ATOMIC_RELAXED, __HIP_MEMORY_SCOPE_AGENT); }
__device__ __forceinline__ unsigned xb_xcc_id() { return (unsigned)__builtin_amdgcn_s_getreg((3 << 11) | 20) & 0xFu; }
#define XB_SPIN(cond, bar) do { unsigned _sp = 0; while (cond) { __builtin_amdgcn_s_sleep(1); \
    if ((++_sp & 255u) == 0u) { if (xb_ld(&(bar)[XB_TMO])) break; if (_sp > XB_SPIN_CAP) { atomicAdd(&(bar)[XB_TMO], 1u); break; } } } } while (0)
struct XcdBarrier { unsigned* bar; unsigned x; volatile LAS unsigned* st; };
__device__ __forceinline__ XcdBarrier xcd_barrier_post(unsigned* bar, volatile LAS unsigned* st) {
    XcdBarrier b; b.bar = bar; b.x = xb_xcc_id(); b.st = st;
    if (threadIdx.x == 0) (void)xb_add(&bar[XB_XCNT(b.x)], 1u);
    return b;
}
__device__ __forceinline__ void xcd_barrier_complete(unsigned* bar, unsigned x, unsigned& nloc, unsigned& nx) {
    const unsigned G = gridDim.x * gridDim.y * gridDim.z;
    unsigned sum, cnt, mine, sp = 0u;
    for (;;) {
        sum = 0u; cnt = 0u; mine = 0u;
#pragma unroll
        for (unsigned j = 0; j < 16; ++j) { const unsigned c = xb_ld(&bar[XB_XCNT(j)]); sum += c; cnt += (c > 0u) ? 1u : 0u; mine = (j == x) ? c : mine; }
        if (sum == G) break;
        __builtin_amdgcn_s_sleep(1);
        if ((++sp & 255u) == 0u) { if (xb_ld(&bar[XB_TMO])) break; if (sp > XB_SPIN_CAP) { atomicAdd(&bar[XB_TMO], 1u); break; } }
    }
    nloc = mine > 0u ? mine : 1u; nx = cnt > 0u ? cnt : 1u;
}
__device__ __forceinline__ void xcd_barrier(const XcdBarrier& b) {
    asm volatile("s_waitcnt vmcnt(0)" ::: "memory");
    __syncthreads();
    if (threadIdx.x == 0) {
        unsigned* bar = b.bar;
        __builtin_amdgcn_s_waitcnt(0);
        unsigned nloc = b.st[0], nx = b.st[1];
        if (nloc == 0u) { xcd_barrier_complete(bar, b.x, nloc, nx); b.st[0] = nloc; b.st[1] = nx; }
        const unsigned old = xb_add(&bar[XB_XSUB(b.x)], 1u);
        const unsigned gen = old / nloc;
        if (old + 1u == (gen + 1u) * nloc) {
            __builtin_amdgcn_fence(__ATOMIC_RELEASE, "agent");
            asm volatile("s_waitcnt vmcnt(0)" ::: "memory");
            const unsigned og = xb_add(&bar[XB_TOP], 1u);
            const unsigned tg = og / nx;
            if (og + 1u == (tg + 1u) * nx) xb_add(&bar[XB_TOPGEN], 1u);
            else XB_SPIN(xb_ld(&bar[XB_TOPGEN]) == tg, bar);
            __builtin_amdgcn_fence(__ATOMIC_ACQUIRE, "agent");
            xb_add(&bar[XB_XGEN(b.x)], 1u);
            asm volatile("s_waitcnt vmcnt(0)" ::: "memory");
        } else {
            XB_SPIN(xb_ld(&bar[XB_XGEN(b.x)]) == gen, bar);
            __builtin_amdgcn_fence(__ATOMIC_ACQUIRE, "agent");
            asm volatile("s_waitcnt vmcnt(0)" ::: "memory");
        }
    }
    __syncthreads();
}

namespace pg8 {
constexpr int BM = 256, BK = 64, HALF = 128, HTB = HALF * BK * 2, STAGE_BYTES = 8 * HTB, NXCD = 8, WGM = 8;
__host__ __device__ __forceinline__ int lds_byte(int r, int c) { const int st = (r >> 4) * 2 + (c >> 5), rr = r & 15, cc = c & 31, ob = rr * 64 + cc * 2; return st * 1024 + (ob ^ (((ob >> 9) & 1) << 5)); }
__host__ __device__ __forceinline__ void stage_rc(int b, int& R, int& C) { const int st = b / 1024, sb = b % 1024, swz = sb ^ (((sb >> 9) & 1) << 5); R = (st >> 1) * 16 + swz / 64; C = (st & 1) * 32 + (swz % 64) / 2; }
__host__ __device__ __forceinline__ int perm32(int rho) { const int n = rho >> 4, i = rho & 15; return 8 * (i >> 2) + 4 * n + (i & 3); }
struct Unit { int pm, pn; };
struct Gemm { const bf16_t* A; int lda; const bf16_t* Bt; int K; };
struct Order {
    int nM, nN, nwg, G, c;
    long a_mul;
    int e_div; long e_mul;
    long bn_mul;
    int pm_ctx0; int e_ctx_base;
    int d_mode;
    __device__ void init(int nM_, int nN_, int G_, int c_, long a_mul_, long bn_mul_) { nM = nM_; nN = nN_; nwg = nM * nN; G = G_; c = c_; a_mul = a_mul_; bn_mul = bn_mul_; e_div = 1 << 30; e_mul = 0; pm_ctx0 = 1 << 30; e_ctx_base = 0; d_mode = 0; }
    __device__ bool next(int i, Unit& u) const {
        const long L = (long)i * G + c; if (L >= nwg) return false;
        int wgid = (int)L; { const int q = nwg / NXCD, r = nwg % NXCD, xcd = wgid % NXCD, off = wgid / NXCD; wgid = (xcd < r ? xcd * (q + 1) : r * (q + 1) + (xcd - r) * q) + off; }
        const int nig = WGM * nN, gid = wgid / nig, fm = gid * WGM, gsz = (nM - fm) < WGM ? (nM - fm) : WGM;
        u.pm = fm + ((wgid % nig) % gsz); u.pn = (wgid % nig) / gsz; return true;
    }
    __device__ __forceinline__ long a_off(const Unit& u) const { const long grp = d_mode ? (u.pn < 2 ? 0 : (u.pn < 4 ? 1 : 2)) : 0; return (long)u.pm * a_mul + grp * ((long)TA * 256); }
    __device__ __forceinline__ long b_off(const Unit& u) const { const int e = (u.pm >= pm_ctx0) ? (u.pm - pm_ctx0) : (u.pm / e_div); return (long)e * e_mul + (long)u.pn * bn_mul; }
};

template <class Epi, bool GATHER = false>
__device__ __forceinline__ void gemm_phase(LAS unsigned char* lds, const Gemm g, const Order& S, const Epi& E, const int* rowidx = nullptr) {
    constexpr bool ALIGN_EPI = true;
    const int tid = opaque_tid(), wid = __builtin_amdgcn_readfirstlane(tid >> 6), lane = tid & 63, wr = wid >> 2, wc = wid & 3, fr = lane & 15, fq = lane >> 4;
    const int K = g.K, nt = K / BK, lda = g.lda;
    unsigned voffA[2], voffB[2];
#pragma unroll
    for (int i = 0; i < 2; ++i) { int R, C; stage_rc(tid * 16 + i * 8192, R, C); const int Rb = Epi::PERM ? ((R & ~31) + perm32(R & 31)) : R;
        voffA[i] = (unsigned)(R * lda + C) * 2u; voffB[i] = (unsigned)(Rb * K + C) * 2u; }
    const size_t kstep = (size_t)(BK * 2);
    const size_t hstepA = (size_t)HALF * lda * 2, hstepB = (size_t)HALF * K * 2;
    const unsigned ldsw = (unsigned)wid * 1024u;
    const int aoff = lds_byte(wr * 64 + fr, fq * 8), boff = lds_byte(wc * 32 + fr, fq * 8);
    unsigned vc[2][2], vn[2][2];
    const char* gA = (const char*)g.A;
#define PG8_SA(b, h) (((b) * 2 + (h)) * HTB)
#define PG8_SB(b, h) ((4 + (b) * 2 + (h)) * HTB)
#define PG8_STAGE(bufoff, gbase, voff) do { _Pragma("unroll") for (int _i = 0; _i < 2; ++_i) \
        __builtin_amdgcn_global_load_lds((const unsigned*)((const char*)(gbase) + (voff)[_i]), (LAS unsigned*)(lds + (bufoff) + ldsw + _i * 8192), 16, 0, 0); } while (0)
#define PG8_STA(bufoff, h, nx, kb) do { if constexpr (GATHER) { unsigned o_[2]; o_[0] = (nx) ? vn[h][0] : vc[h][0]; o_[1] = (nx) ? vn[h][1] : vc[h][1]; PG8_STAGE(bufoff, gA + (kb), o_); } \
        else { PG8_STAGE(bufoff, ((nx) ? nA : cA) + (size_t)(h) * hstepA + (kb), voffA); } } while (0)
#define PG8_LOADIDX(dst, unit) do { _Pragma("unroll") for (int i_ = 0; i_ < 2; ++i_) { int R_, C_; stage_rc(tid * 16 + i_ * 8192, R_, C_); \
        _Pragma("unroll") for (int h_ = 0; h_ < 2; ++h_) dst[h_][i_] = (unsigned)rowidx[(unit).pm * BM + h_ * HALF + R_] * (unsigned)(lda * 2) + (unsigned)(C_ * 2); } } while (0)
#define PG8_LDA(dst, b, h) do { _Pragma("unroll") for (int m = 0; m < 4; ++m) _Pragma("unroll") for (int k = 0; k < 2; ++k) dst[m][k] = *(const LAS bf16x8*)(lds + PG8_SA(b, h) + aoff + m * 2048 + k * 1024); } while (0)
#define PG8_LDB(dst, b, h) do { _Pragma("unroll") for (int n = 0; n < 2; ++n) _Pragma("unroll") for (int k = 0; k < 2; ++k) dst[n][k] = *(const LAS bf16x8*)(lds + PG8_SB(b, h) + boff + n * 2048 + k * 1024); } while (0)
#define PG8_MMA(ai, bj, At, Bt) do { __builtin_amdgcn_s_setprio(1); _Pragma("unroll") for (int m = 0; m < 4; ++m) _Pragma("unroll") for (int n = 0; n < 2; ++n) _Pragma("unroll") for (int k = 0; k < 2; ++k) \
        acc[ai][bj][m][n] = __builtin_amdgcn_mfma_f32_16x16x32_bf16(Bt[n][k], At[m][k], acc[ai][bj][m][n], 0, 0, 0); __builtin_amdgcn_s_setprio(0); } while (0)
#define PG8_WAIT_V(n) asm volatile("s_waitcnt vmcnt(" #n ")" ::: "memory")
#define PG8_WAIT_L(n) asm volatile("s_waitcnt lgkmcnt(" #n ")" ::: "memory")
#define PG8_BAR __builtin_amdgcn_s_barrier()
#define PG8_SCHED __builtin_amdgcn_sched_barrier(0)
    Unit cur, nxt; int ui = 0;
    if (!S.next(0, cur)) return;
    f32x4 acc[2][2][4][2];
#pragma unroll
    for (int a = 0; a < 2; ++a)
#pragma unroll
        for (int b = 0; b < 2; ++b)
#pragma unroll
            for (int m = 0; m < 4; ++m)
#pragma unroll
                for (int n = 0; n < 2; ++n) acc[a][b][m][n] = (f32x4){0.f, 0.f, 0.f, 0.f};
    bf16x8 At[4][2], B0[2][2], B1[2][2];
    const char* cA = GATHER ? gA : (const char*)(g.A + S.a_off(cur)); const char* cB = (const char*)(g.Bt + S.b_off(cur));
    const char* nA = cA;
    if constexpr (GATHER) { PG8_LOADIDX(vc, cur); }
    PG8_STAGE(PG8_SB(0, 0), cB, voffB); PG8_STAGE(PG8_SB(0, 1), cB + hstepB, voffB); PG8_STA(PG8_SA(0, 0), 0, false, 0); PG8_STA(PG8_SA(0, 1), 1, false, 0);
    if (wr == 1) PG8_BAR;
    PG8_WAIT_V(2); PG8_BAR;
    PG8_STAGE(PG8_SB(1, 0), cB + kstep, voffB); PG8_STA(PG8_SA(1, 0), 0, false, kstep); PG8_STAGE(PG8_SB(1, 1), cB + hstepB + kstep, voffB);
    PG8_WAIT_V(6); PG8_BAR;
    for (;;) {
        const bool has_next = S.next(ui + 1, nxt);
        if constexpr (GATHER) { if (has_next) { PG8_LOADIDX(vn, nxt); } else { vn[0][0] = vc[0][0]; vn[0][1] = vc[0][1]; vn[1][0] = vc[1][0]; vn[1][1] = vc[1][1]; } }
        else nA = has_next ? (const char*)(g.A + S.a_off(nxt)) : cA;
        const char* nB = has_next ? (const char*)(g.Bt + S.b_off(nxt)) : cB;
#pragma unroll 1
        for (int t = 0; t < nt; t += 2) {
            const bool last = (t == nt - 2);
            const size_t k1 = (size_t)(t + 1) * kstep, k2 = last ? 0 : (size_t)(t + 2) * kstep, k3 = k2 + kstep;
            const char* b2 = last ? nB : cB + (size_t)(t + 2) * kstep; const char* b3 = b2 + kstep;
            PG8_LDB(B0, 0, 0); PG8_LDB(B1, 0, 1); PG8_SCHED; PG8_LDA(At, 0, 0); PG8_STA(PG8_SA(1, 1), 1, false, k1);
            PG8_WAIT_V(8); PG8_WAIT_L(0); PG8_BAR; PG8_MMA(0, 0, At, B0); PG8_MMA(0, 1, At, B1); PG8_BAR; PG8_SCHED;
            PG8_LDA(At, 0, 1); PG8_STAGE(PG8_SB(0, 0), b2, voffB); PG8_STAGE(PG8_SB(0, 1), b2 + hstepB, voffB); PG8_STA(PG8_SA(0, 0), 0, last, k2);
            PG8_WAIT_V(8); PG8_WAIT_L(0); PG8_BAR; PG8_MMA(1, 0, At, B0); PG8_MMA(1, 1, At, B1); PG8_BAR; PG8_SCHED;
            PG8_LDB(B0, 1, 0); PG8_LDB(B1, 1, 1); PG8_SCHED; PG8_LDA(At, 1, 0); PG8_STA(PG8_SA(0, 1), 1, last, k2);
            PG8_WAIT_V(8); PG8_WAIT_L(0); PG8_BAR; PG8_MMA(0, 0, At, B0); PG8_MMA(0, 1, At, B1); PG8_BAR; PG8_SCHED;
            PG8_LDA(At, 1, 1); PG8_STAGE(PG8_SB(1, 0), b3, voffB); PG8_STAGE(PG8_SB(1, 1), b3 + hstepB, voffB); PG8_STA(PG8_SA(1, 0), 0, last, k3);
            PG8_WAIT_V(8); PG8_WAIT_L(0); PG8_BAR; PG8_MMA(1, 0, At, B0); PG8_MMA(1, 1, At, B1); PG8_BAR; PG8_SCHED;
        }
        if constexpr (ALIGN_EPI) { if (wr == 0) PG8_BAR; }
        E(acc, cur, wr, wc, fr, fq);
        if (!has_next) break;
#pragma unroll
        for (int a = 0; a < 2; ++a)
#pragma unroll
            for (int b = 0; b < 2; ++b)
#pragma unroll
                for (int m = 0; m < 4; ++m)
#pragma unroll
                    for (int n = 0; n < 2; ++n) acc[a][b][m][n] = (f32x4){0.f, 0.f, 0.f, 0.f};
        cur = nxt; cA = nA; cB = nB; ++ui;
        if constexpr (GATHER) { vc[0][0] = vn[0][0]; vc[0][1] = vn[0][1]; vc[1][0] = vn[1][0]; vc[1][1] = vn[1][1]; }
        if constexpr (ALIGN_EPI) { if (wr == 1) PG8_BAR; }
    }
    PG8_WAIT_V(0);
    PG8_BAR;
#undef PG8_SA
#undef PG8_SB
#undef PG8_STAGE
#undef PG8_STA
#undef PG8_LOADIDX
#undef PG8_LDA
#undef PG8_LDB
#undef PG8_MMA
#undef PG8_WAIT_V
#undef PG8_WAIT_L
#undef PG8_BAR
#undef PG8_SCHED
}
typedef f32x4 Acc[2][2][4][2];

struct EpiStore {
    static constexpr bool PERM = true;
    bf16_t* O0; int ld0; bf16_t* O1; int ld1; int split_pn;
    __device__ __forceinline__ void operator()(const Acc& acc, const Unit& u, int wr, int wc, int fr, int fq) const {
        const int row0 = u.pm * BM + wr * 64 + fr;
        bf16_t* base; int ld, colt;
        if (u.pn < split_pn) { base = O0; ld = ld0; colt = u.pn * 256; } else { base = O1; ld = ld1; colt = (u.pn - split_pn) * 256; }
        const int col0 = colt + wc * 32 + 8 * fq;
#pragma unroll
        for (int ai = 0; ai < 2; ++ai)
#pragma unroll
            for (int m = 0; m < 4; ++m) { bf16_t* rowp = base + (size_t)(row0 + ai * HALF + m * 16) * ld + col0;
#pragma unroll
                for (int bj = 0; bj < 2; ++bj) { const f32x4 v0 = acc[ai][bj][m][0], v1 = acc[ai][bj][m][1];
                    u32x4 w; w.x = pk2(v0[0], v0[1]); w.y = pk2(v0[2], v0[3]); w.z = pk2(v1[0], v1[1]); w.w = pk2(v1[2], v1[3]);
                    *(u32x4*)(rowp + bj * HALF) = w; } }
    }
};
struct EpiQ {
    static constexpr bool PERM = true;
    bf16_t* O; const float* ropec; const float* ropes;
    __device__ __forceinline__ void operator()(const Acc& acc, const Unit& u, int wr, int wc, int fr, int fq) const {
        const int row0 = u.pm * BM + wr * 64 + fr;
#pragma unroll
        for (int bj = 0; bj < 2; ++bj) {
            const int cb = u.pn * 256 + bj * HALF + wc * 32;
            if (cb >= 384) continue;
            const int hh = cb / 96, dd = cb - hh * 96; const bool rope = (dd == 64);
#pragma unroll
            for (int ai = 0; ai < 2; ++ai)
#pragma unroll
                for (int m = 0; m < 4; ++m) {
                    const int row = row0 + ai * HALF + m * 16;
                    f32x4 v0 = acc[ai][bj][m][0], v1 = acc[ai][bj][m][1];
                    if (rope) {
                        f32x4 p0, p1;
#pragma unroll
                        for (int j = 0; j < 4; ++j) { p0[j] = __shfl_xor(v0[j], 16); p1[j] = __shfl_xor(v1[j], 16); }
                        if (row < TL) {
                            const int t = row & (SEQ - 1); const int pos = (fq < 2) ? (t >> 6) : (t & 63);
                            const f32x4 c0 = *(const f32x4*)(ropec + pos * 8), c1 = *(const f32x4*)(ropec + pos * 8 + 4);
                            const f32x4 s0 = *(const f32x4*)(ropes + pos * 8), s1 = *(const f32x4*)(ropes + pos * 8 + 4);
                            if ((fq & 1) == 0) { v0 = v0 * c0 - p0 * s0; v1 = v1 * c1 - p1 * s1; }
                            else               { v0 = p0 * s0 + v0 * c0; v1 = p1 * s1 + v1 * c1; }
                        }
                    }
                    v0 = v0 * QSCALE_MLA; v1 = v1 * QSCALE_MLA;
                    u32x4 w; w.x = pk2(v0[0], v0[1]); w.y = pk2(v0[2], v0[3]); w.z = pk2(v1[0], v1[1]); w.w = pk2(v1[2], v1[3]);
                    *(u32x4*)(O + (size_t)row * 384 + cb + 8 * fq) = w;
                    asm volatile("" ::: "memory");
                }
        }
    }
};
struct EpiPool {
    static constexpr bool PERM = true;
    bf16_t* O; const float* scale; float* ssg;
    __device__ __forceinline__ void operator()(const Acc& acc, const Unit& u, int wr, int wc, int fr, int fq) const {
        const int row0 = u.pm * BM + wr * 64 + fr; const int col0 = wc * 32 + 8 * fq;
        f32x4 sc[2][2];
#pragma unroll
        for (int bj = 0; bj < 2; ++bj)
#pragma unroll
            for (int n = 0; n < 2; ++n) sc[bj][n] = *(const f32x4*)(scale + col0 + bj * HALF + 4 * n);
#pragma unroll
        for (int ai = 0; ai < 2; ++ai)
#pragma unroll
            for (int m = 0; m < 4; ++m) { const int row = row0 + ai * HALF + m * 16; float ss = 0.f;
#pragma unroll
                for (int bj = 0; bj < 2; ++bj) { const f32x4 v0 = acc[ai][bj][m][0] * sc[bj][0], v1 = acc[ai][bj][m][1] * sc[bj][1];
                    ss += (v0[0] * v0[0] + v0[1] * v0[1]) + (v0[2] * v0[2] + v0[3] * v0[3]) + (v1[0] * v1[0] + v1[1] * v1[1]) + (v1[2] * v1[2] + v1[3] * v1[3]);
                    u32x4 w; w.x = pk2(v0[0], v0[1]); w.y = pk2(v0[2], v0[3]); w.z = pk2(v1[0], v1[1]); w.w = pk2(v1[2], v1[3]);
                    *(u32x4*)(O + (size_t)row * 1024 + CC_B + col0 + bj * HALF) = w; }
                ss += __shfl_xor(ss, 16); ss += __shfl_xor(ss, 32);
                if (fq == 0) ssg[(size_t)row * 16 + 4 + wc] = ss; }
    }
};
struct EpiD {
    static constexpr bool PERM = true;
    EpiQ q; EpiStore kv; EpiPool pool;
    __device__ __forceinline__ void operator()(const Acc& acc, const Unit& u, int wr, int wc, int fr, int fq) const {
        if (u.pn < 2) q(acc, u, wr, wc, fr, fq);
        else if (u.pn < 4) { Unit v = u; v.pn = u.pn - 2; kv(acc, v, wr, wc, fr, fq); }
        else { Unit v = u; v.pn = 0; pool(acc, v, wr, wc, fr, fq); }
    }
};
struct EpiRes {
    static constexpr bool PERM = true;
    const float* baseLf; const bf16_t* baseLb; const float* baseC; bf16_t* outL; float* outC; const float* mods;
    __device__ __forceinline__ void operator()(const Acc& acc, const Unit& u, int wr, int wc, int fr, int fq) const {
        const int row0 = u.pm * BM + wr * 64 + fr; const int col0 = u.pn * BM + wc * 32 + 8 * fq;
        const bool lat = (u.pm * BM < TL); const int bidx = lat ? ((u.pm * BM) >> 13) : 4;
        const float* gp = mods + bidx * 6144 + 2048;
        f32x4 gv[2][2];
#pragma unroll
        for (int bj = 0; bj < 2; ++bj)
#pragma unroll
            for (int n = 0; n < 2; ++n) gv[bj][n] = *(const f32x4*)(gp + col0 + bj * HALF + 4 * n);
#pragma unroll
        for (int ai = 0; ai < 2; ++ai)
#pragma unroll
            for (int m = 0; m < 4; ++m) { const int row = row0 + ai * HALF + m * 16;
#pragma unroll
                for (int bj = 0; bj < 2; ++bj) { const int c = col0 + bj * HALF; f32x4 b0, b1;
                    if (lat) {
                        if (baseLf) { b0 = *(const f32x4*)(baseLf + (size_t)row * 1024 + c); b1 = *(const f32x4*)(baseLf + (size_t)row * 1024 + c + 4); }
                        else { const u32x4 w = *(const u32x4*)(baseLb + (size_t)row * 1024 + c); b0 = (f32x4){bflo(w.x), bfhi(w.x), bflo(w.y), bfhi(w.y)}; b1 = (f32x4){bflo(w.z), bfhi(w.z), bflo(w.w), bfhi(w.w)}; }
                        const f32x4 r0 = b0 + gv[bj][0] * acc[ai][bj][m][0], r1 = b1 + gv[bj][1] * acc[ai][bj][m][1];
                        u32x4 o; o.x = pk2(r0[0], r0[1]); o.y = pk2(r0[2], r0[3]); o.z = pk2(r1[0], r1[1]); o.w = pk2(r1[2], r1[3]);
                        *(u32x4*)(outL + (size_t)row * 1024 + c) = o;
                    } else { const size_t ro = (size_t)(row - TL) * 1024 + c;
                        b0 = *(const f32x4*)(baseC + ro); b1 = *(const f32x4*)(baseC + ro + 4);
                        *(f32x4*)(outC + ro) = b0 + gv[bj][0] * acc[ai][bj][m][0]; *(f32x4*)(outC + ro + 4) = b1 + gv[bj][1] * acc[ai][bj][m][1]; } } }
    }
};
struct EpiSwiGLU {
    static constexpr bool PERM = true;
    bf16_t* O;
    __device__ __forceinline__ void operator()(const Acc& acc, const Unit& u, int wr, int wc, int fr, int fq) const {
        const int row0 = u.pm * BM + wr * 64 + fr; const int col0 = u.pn * 128 + wc * 32 + 8 * fq;
#pragma unroll
        for (int ai = 0; ai < 2; ++ai)
#pragma unroll
            for (int m = 0; m < 4; ++m) { const int row = row0 + ai * HALF + m * 16; float h[8];
#pragma unroll
                for (int n = 0; n < 2; ++n)
#pragma unroll
                    for (int j = 0; j < 4; ++j) { const float gt = acc[ai][0][m][n][j], up = acc[ai][1][m][n][j]; h[n * 4 + j] = gt * __builtin_amdgcn_rcpf(1.f + __expf(-gt)) * up; }
                u32x4 w; w.x = pk2(h[0], h[1]); w.y = pk2(h[2], h[3]); w.z = pk2(h[4], h[5]); w.w = pk2(h[6], h[7]);
                *(u32x4*)(O + (size_t)row * 1024 + col0) = w; }
    }
};
struct EpiGate {
    static constexpr bool PERM = true;
    bf16_t* O; const float* gate;
    __device__ __forceinline__ void operator()(const Acc& acc, const Unit& u, int wr, int wc, int fr, int fq) const {
        const int row0 = u.pm * BM + wr * 64 + fr; const int col0 = u.pn * 256 + wc * 32 + 8 * fq;
#pragma unroll
        for (int ai = 0; ai < 2; ++ai)
#pragma unroll
            for (int m = 0; m < 4; ++m) { const int row = row0 + ai * HALF + m * 16; const float gsc = gate[row];
                bf16_t* rowp = O + (size_t)row * 1024 + col0;
#pragma unroll
                for (int bj = 0; bj < 2; ++bj) { const f32x4 v0 = acc[ai][bj][m][0] * gsc, v1 = acc[ai][bj][m][1] * gsc;
                    u32x4 w; w.x = pk2(v0[0], v0[1]); w.y = pk2(v0[2], v0[3]); w.z = pk2(v1[0], v1[1]); w.w = pk2(v1[2], v1[3]);
                    *(u32x4*)(rowp + bj * HALF) = w; } }
    }
};
}

#define KSWZ(row, colB) ((row) * 256 + ((colB) ^ (((row) & 15) << 4)))
__device__ __forceinline__ int crow(int r, int hi) { return (r & 3) + 8 * (r >> 2) + 4 * hi; }
__device__ __forceinline__ int v_st(int k, int c) { const int kk = (k & ~0xC) | ((k & 4) << 1) | ((k & 8) >> 1); return ((kk >> 3) * 4 + (c >> 5)) * 512 + ((kk & 7) * 32 + (c & 31)) * 2; }
__device__ __forceinline__ int v_rd_base(int lane) { return ((lane & 3) << 3) | (((lane >> 2) & 3) << 6) | (((lane >> 4) & 1) << 5) | (((lane >> 5) & 1) << 8); }
constexpr int v_rd_off(int d0, int ks, int half) { return d0 * 512 + ks * 4096 + half * 2048; }
template <int OFF> __device__ __forceinline__ s16x4 tr_read(int vb) {
    s16x4 r; asm volatile("ds_read_b64_tr_b16 %0, %1 offset:%2" : "=&v"(r) : "v"(vb), "i"(OFF) : "memory"); return r;
}
template <int D0> __device__ __forceinline__ void pv_one(f32x16& od, int vb, bf16x8 pa0, bf16x8 pa1, bf16x8 pa2, bf16x8 pa3) {
    const s16x4 l0 = tr_read<v_rd_off(D0, 0, 0)>(vb), h0 = tr_read<v_rd_off(D0, 0, 1)>(vb), l1 = tr_read<v_rd_off(D0, 1, 0)>(vb), h1 = tr_read<v_rd_off(D0, 1, 1)>(vb);
    const s16x4 l2 = tr_read<v_rd_off(D0, 2, 0)>(vb), h2 = tr_read<v_rd_off(D0, 2, 1)>(vb), l3 = tr_read<v_rd_off(D0, 3, 0)>(vb), h3 = tr_read<v_rd_off(D0, 3, 1)>(vb);
    asm volatile("s_waitcnt lgkmcnt(0)" ::: "memory"); SBAR();
#define PK(L, H) (bf16x8){L[0], L[1], L[2], L[3], H[0], H[1], H[2], H[3]}
    od = __builtin_amdgcn_mfma_f32_32x32x16_bf16(pa0, PK(l0, h0), od, 0, 0, 0);
    od = __builtin_amdgcn_mfma_f32_32x32x16_bf16(pa1, PK(l1, h1), od, 0, 0, 0);
    od = __builtin_amdgcn_mfma_f32_32x32x16_bf16(pa2, PK(l2, h2), od, 0, 0, 0);
    od = __builtin_amdgcn_mfma_f32_32x32x16_bf16(pa3, PK(l3, h3), od, 0, 0, 0);
#undef PK
}
__device__ __forceinline__ void stage_vtile(char* tile, const bf16_t* src, long pitch) {
    const int tid = opaque_tid(), sr = tid >> 4, sc = (tid & 15) * 8;
    const bf16x8 a = *(const bf16x8*)(src + (long)sr * pitch + sc), b = *(const bf16x8*)(src + (long)(32 + sr) * pitch + sc);
    *(bf16x8*)(tile + v_st(sr, sc)) = a; *(bf16x8*)(tile + v_st(32 + sr, sc)) = b;
}

struct AttnDesc {
    unsigned q_off;
    unsigned ka_off, kb_off, v_off;
    unsigned o_off, ss_off;
    int first_base, n_first, second_base, clampmax, NT;
    int qy0, R0;
    int nrows;
};
constexpr int SHM_V = 16384, SHM_K = 16384, ATT_NBUF = 3;
constexpr int ATT_K_OFF = ATT_NBUF * SHM_V, ATT_WS_OFF = ATT_NBUF * (SHM_V + SHM_K), ATT_BIAS_OFF = ATT_WS_OFF + 8 * 64 * 4;

template <int D0> __device__ __forceinline__ void pv_two(f32x16& o0, f32x16& o1, int vb, const bf16x8 (&pa)[2][4]) {
    const s16x4 l0 = tr_read<v_rd_off(D0, 0, 0)>(vb), h0 = tr_read<v_rd_off(D0, 0, 1)>(vb), l1 = tr_read<v_rd_off(D0, 1, 0)>(vb), h1 = tr_read<v_rd_off(D0, 1, 1)>(vb);
    const s16x4 l2 = tr_read<v_rd_off(D0, 2, 0)>(vb), h2 = tr_read<v_rd_off(D0, 2, 1)>(vb), l3 = tr_read<v_rd_off(D0, 3, 0)>(vb), h3 = tr_read<v_rd_off(D0, 3, 1)>(vb);
    asm volatile("s_waitcnt lgkmcnt(0)" ::: "memory"); SBAR();
#define PK(L, H) (bf16x8){L[0], L[1], L[2], L[3], H[0], H[1], H[2], H[3]}
    o0 = __builtin_amdgcn_mfma_f32_32x32x16_bf16(pa[0][0], PK(l0, h0), o0, 0, 0, 0); o1 = __builtin_amdgcn_mfma_f32_32x32x16_bf16(pa[1][0], PK(l0, h0), o1, 0, 0, 0);
    o0 = __builtin_amdgcn_mfma_f32_32x32x16_bf16(pa[0][1], PK(l1, h1), o0, 0, 0, 0); o1 = __builtin_amdgcn_mfma_f32_32x32x16_bf16(pa[1][1], PK(l1, h1), o1, 0, 0, 0);
    o0 = __builtin_amdgcn_mfma_f32_32x32x16_bf16(pa[0][2], PK(l2, h2), o0, 0, 0, 0); o1 = __builtin_amdgcn_mfma_f32_32x32x16_bf16(pa[1][2], PK(l2, h2), o1, 0, 0, 0);
    o0 = __builtin_amdgcn_mfma_f32_32x32x16_bf16(pa[0][3], PK(l3, h3), o0, 0, 0, 0); o1 = __builtin_amdgcn_mfma_f32_32x32x16_bf16(pa[1][3], PK(l3, h3), o1, 0, 0, 0);
#undef PK
}

__device__ __forceinline__ void pv_four(f32x16 (&o)[2][2], int vb, const bf16x8 (&pa)[2][4]) {
    const s16x4 l0 = tr_read<v_rd_off(0, 0, 0)>(vb), h0 = tr_read<v_rd_off(0, 0, 1)>(vb), l1 = tr_read<v_rd_off(0, 1, 0)>(vb), h1 = tr_read<v_rd_off(0, 1, 1)>(vb);
    const s16x4 l2 = tr_read<v_rd_off(0, 2, 0)>(vb), h2 = tr_read<v_rd_off(0, 2, 1)>(vb), l3 = tr_read<v_rd_off(0, 3, 0)>(vb), h3 = tr_read<v_rd_off(0, 3, 1)>(vb);
    const s16x4 m0 = tr_read<v_rd_off(1, 0, 0)>(vb), n0 = tr_read<v_rd_off(1, 0, 1)>(vb), m1 = tr_read<v_rd_off(1, 1, 0)>(vb), n1 = tr_read<v_rd_off(1, 1, 1)>(vb);
    const s16x4 m2 = tr_read<v_rd_off(1, 2, 0)>(vb), n2 = tr_read<v_rd_off(1, 2, 1)>(vb), m3 = tr_read<v_rd_off(1, 3, 0)>(vb), n3 = tr_read<v_rd_off(1, 3, 1)>(vb);
    asm volatile("s_waitcnt lgkmcnt(0)" ::: "memory"); SBAR();
#define PK(L, H) (bf16x8){L[0], L[1], L[2], L[3], H[0], H[1], H[2], H[3]}
#define STEP4(k, LA, HA, LB, HB) do { \
    o[0][0] = __builtin_amdgcn_mfma_f32_32x32x16_bf16(pa[0][k], PK(LA, HA), o[0][0], 0, 0, 0); o[1][0] = __builtin_amdgcn_mfma_f32_32x32x16_bf16(pa[1][k], PK(LA, HA), o[1][0], 0, 0, 0); \
    o[0][1] = __builtin_amdgcn_mfma_f32_32x32x16_bf16(pa[0][k], PK(LB, HB), o[0][1], 0, 0, 0); o[1][1] = __builtin_amdgcn_mfma_f32_32x32x16_bf16(pa[1][k], PK(LB, HB), o[1][1], 0, 0, 0); } while (0)
    STEP4(0, l0, h0, m0, n0); STEP4(1, l1, h1, m1, n1); STEP4(2, l2, h2, m2, n2); STEP4(3, l3, h3, m3, n3);
#undef STEP4
#undef PK
}

template <int DQK, bool NA>
__device__ __forceinline__ void attn_unit(const AttnDesc d, const unsigned char* wsb, char* lds) {
    constexpr int ND = DQK / 16;
    constexpr unsigned LDQ = NA ? DINP : 384, LDKA = NA ? DINP : 256, LDKB = NA ? DINP : 32, LDV = NA ? DINP : 256;
    constexpr float THRL = 8.f * 1.4426950408889634f;
    const int tid = opaque_tid(), wid = __builtin_amdgcn_readfirstlane(tid >> 6), lane = tid & 63, r32 = lane & 31, hi = lane >> 5;
    char* V_lds = lds; char* K_lds = lds + ATT_K_OFF;
    float* wsf = (float*)(lds + ATT_WS_OFF) + wid * 64; float* li_l = wsf; float* al_l = wsf + 32;
    const float* bias = (const float*)(lds + ATT_BIAS_OFF);
    float m_reg[2] = {0.f, 0.f}, l_reg[2] = {0.f, 0.f}; f32x16 o[2][2]; bf16x8 qr[2][ND];
#pragma unroll
    for (int qb = 0; qb < 2; ++qb) { o[qb][0] = f32x16{}; o[qb][1] = f32x16{};
        const bf16_t* Qw = (const bf16_t*)(wsb + d.q_off) + (unsigned)(wid * 64 + qb * 32 + r32) * LDQ + hi * 8;
#pragma unroll
        for (int d0 = 0; d0 < ND; ++d0) qr[qb][d0] = *(const bf16x8*)(Qw + d0 * 16); }
    const int sr = NA ? (tid >> 3) : (tid >> 4), sc = NA ? (tid & 7) * 8 : (tid & 15) * 8, vst0 = v_st(sr, sc), vst1 = v_st(32 + sr, sc);
    const int vb0 = (int)(uintptr_t)V_lds + v_rd_base(lane);
    const unsigned krow = ((sc < 64) ? LDKA : LDKB) * 2u, kcol = (sc < 64) ? d.ka_off + sc * 2u : d.kb_off + ((sc - 64) & 31) * 2u;
    const unsigned vrow = LDV * 2u, vcol = d.v_off + (sc & 63) * 2u;
    const int qy = d.qy0 + wid;
    const int rs = min(max(qy - 4, 0), 120);
    const int NT = d.NT;
    bf16x8 vs0, vs1, ks0, ks1;
#define TOKB(t) (((t) < d.n_first) ? d.first_base + 64 * (t) : d.second_base + 64 * min((t) - d.n_first, d.clampmax))
#define TVALID(t) (true)
#define KLOAD(t) do { const unsigned t0_ = (unsigned)(TOKB(min((t), NT - 1)) + sr); ks0 = *(const bf16x8*)(wsb + (t0_ * krow + kcol)); \
    if constexpr (!NA) ks1 = *(const bf16x8*)(wsb + ((t0_ + 32u) * krow + kcol)); } while (0)
#define VLOAD(t) do { const unsigned t0_ = (unsigned)(TOKB(min((t), NT - 1)) + sr); vs0 = *(const bf16x8*)(wsb + (t0_ * vrow + vcol)); \
    if constexpr (!NA) vs1 = *(const bf16x8*)(wsb + ((t0_ + 32u) * vrow + vcol)); } while (0)
#define KWRITE(b) do { if constexpr (NA) { *(bf16x8*)(K_lds + (b) * SHM_K + KSWZ(sr, sc * 2)) = ks0; } \
    else if (sc < DQK) { *(bf16x8*)(K_lds + (b) * SHM_K + KSWZ(sr, sc * 2)) = ks0; *(bf16x8*)(K_lds + (b) * SHM_K + KSWZ(32 + sr, sc * 2)) = ks1; } } while (0)
#define VWRITE(b) do { if constexpr (NA) { *(bf16x8*)(V_lds + (b) * SHM_V + vst0) = vs0; } \
    else if (sc < 64) { *(bf16x8*)(V_lds + (b) * SHM_V + vst0) = vs0; *(bf16x8*)(V_lds + (b) * SHM_V + vst1) = vs1; } } while (0)
#define VMWAIT() asm volatile("s_waitcnt vmcnt(0)" ::: "memory")
#define PK4(P, BASE, OUT) do { unsigned a0 = pk2(P[BASE + 0], P[BASE + 1]), a1 = pk2(P[BASE + 2], P[BASE + 3]);   \
    unsigned b0 = pk2(P[BASE + 4], P[BASE + 5]), b1 = pk2(P[BASE + 6], P[BASE + 7]);                              \
    auto r0 = __builtin_amdgcn_permlane32_swap(a0, b0, false, false); auto r1 = __builtin_amdgcn_permlane32_swap(a1, b1, false, false); \
    u32x4 w = {r0[0], r1[0], r0[1], r1[1]}; OUT = __builtin_bit_cast(bf16x8, w); } while (0)
    f32x16 p[2][2]; bf16x8 pa[2][4];
    KLOAD(0); VLOAD(0); VMWAIT(); KWRITE(0); VWRITE(0);
    KLOAD(1); VMWAIT(); KWRITE(1);
    KLOAD(2); VLOAD(1);
    __syncthreads();
    if (wid >= 4) __syncthreads();
    int kb = 0, vb = 2;
    for (int j = 0; j < NT; ++j) {
        const bool tv = TVALID(j);
        SBAR(); __builtin_amdgcn_s_setprio(1);
        if (j > 0) pv_four(o, vb0 + vb * SHM_V, pa);
        if (tv) { const char* Ks = K_lds + kb * SHM_K;
            if constexpr (NA) {
                const bool mk = (j >= d.n_first); const int R_ = d.R0 + (j - d.n_first); const bool rowok = (R_ >= rs) && (R_ < rs + 8);
                const float* brow_ = bias + (mk ? min(max(d.R0 + (j - d.n_first) - qy + 7, 0), 14) : 15) * 128 + (63 - r32);
#pragma unroll
                for (int qb = 0; qb < 2; ++qb) { const int cs = min(max(32 * qb + r32 - 8, 0), 48);
#pragma unroll
                    for (int r = 0; r < 16; ++r) { const int kx0 = crow(r, hi), kx1 = kx0 + 32;
                        p[qb][0][r] = (!mk || (rowok && (unsigned)(kx0 - cs) < 16u)) ? brow_[kx0 - 32 * qb] - m_reg[qb] : -INFINITY;
                        p[qb][1][r] = (!mk || (rowok && (unsigned)(kx1 - cs) < 16u)) ? brow_[kx1 - 32 * qb] - m_reg[qb] : -INFINITY; } }
            } else {
#pragma unroll
                for (int qb = 0; qb < 2; ++qb)
#pragma unroll
                    for (int r = 0; r < 16; ++r) { p[qb][0][r] = -m_reg[qb]; p[qb][1][r] = -m_reg[qb]; } }
            bf16x8 kf0 = *(const bf16x8*)(Ks + KSWZ(r32, hi * 16)), kf1 = *(const bf16x8*)(Ks + KSWZ(32 + r32, hi * 16));
#pragma unroll
            for (int d0 = 0; d0 < ND; ++d0) { const bf16x8 b0 = kf0, b1 = kf1;
                if (d0 + 1 < ND) { const int cb = ((d0 + 1) * 16 + hi * 8) * 2; kf0 = *(const bf16x8*)(Ks + KSWZ(r32, cb)); kf1 = *(const bf16x8*)(Ks + KSWZ(32 + r32, cb)); }
                p[0][0] = __builtin_amdgcn_mfma_f32_32x32x16_bf16(b0, qr[0][d0], p[0][0], 0, 0, 0); p[1][0] = __builtin_amdgcn_mfma_f32_32x32x16_bf16(b0, qr[1][d0], p[1][0], 0, 0, 0);
                p[0][1] = __builtin_amdgcn_mfma_f32_32x32x16_bf16(b1, qr[0][d0], p[0][1], 0, 0, 0); p[1][1] = __builtin_amdgcn_mfma_f32_32x32x16_bf16(b1, qr[1][d0], p[1][1], 0, 0, 0); } }
        __builtin_amdgcn_s_setprio(0);
        __syncthreads();
        if (tv) {
#pragma unroll
            for (int qb = 0; qb < 2; ++qb) {
                float pmax = p[qb][0][0];
#pragma unroll
                for (int r = 1; r < 16; ++r) pmax = fmaxf(pmax, p[qb][0][r]);
#pragma unroll
                for (int r = 0; r < 16; ++r) pmax = fmaxf(pmax, p[qb][1][r]);
                { auto rr = __builtin_amdgcn_permlane32_swap(__float_as_uint(pmax), __float_as_uint(pmax), false, false);
                  pmax = fmaxf(__uint_as_float(rr[0]), __uint_as_float(rr[1])); }
                float alpha = 1.f;
                if (__builtin_expect(!__all(pmax <= THRL), 0)) {
                    const float dl = fmaxf(pmax, 0.f); m_reg[qb] += dl; alpha = __builtin_amdgcn_exp2f(-dl);
#pragma unroll
                    for (int r = 0; r < 16; ++r) { p[qb][0][r] -= dl; p[qb][1][r] -= dl; }
                    if (hi == 0) al_l[r32] = alpha; asm volatile("s_waitcnt lgkmcnt(0)" ::: "memory");
#pragma unroll
                    for (int dd = 0; dd < 2; ++dd)
#pragma unroll
                        for (int r = 0; r < 16; ++r) o[qb][dd][r] *= al_l[crow(r, hi)]; }
                float ps0 = 0.f, ps1 = 0.f;
#pragma unroll
                for (int r = 0; r < 16; ++r) { p[qb][0][r] = __builtin_amdgcn_exp2f(p[qb][0][r]); ps0 += p[qb][0][r]; }
#pragma unroll
                for (int r = 0; r < 16; ++r) { p[qb][1][r] = __builtin_amdgcn_exp2f(p[qb][1][r]); ps1 += p[qb][1][r]; }
                float ps = ps0 + ps1;
                { auto rr = __builtin_amdgcn_permlane32_swap(__float_as_uint(ps), __float_as_uint(ps), false, false);
                  ps = __uint_as_float(rr[0]) + __uint_as_float(rr[1]); }
                l_reg[qb] = l_reg[qb] * alpha + ps;
                PK4(p[qb][0], 0, pa[qb][0]); PK4(p[qb][0], 8, pa[qb][1]); PK4(p[qb][1], 0, pa[qb][2]); PK4(p[qb][1], 8, pa[qb][3]);
            }
        } else {
#pragma unroll
            for (int qb = 0; qb < 2; ++qb)
#pragma unroll
                for (int i = 0; i < 4; ++i) pa[qb][i] = (bf16x8){0, 0, 0, 0, 0, 0, 0, 0};
        }
        { const int kw = (kb == 0) ? 2 : kb - 1;
          const int vw = (kb == 2) ? 0 : kb + 1;
          VMWAIT();
          if (j + 2 < NT) KWRITE(kw);
          if (j + 1 < NT) VWRITE(vw);
          KLOAD(j + 3); VLOAD(j + 2); }
        __syncthreads();
        kb = (kb == 2) ? 0 : kb + 1; vb = (vb == 2) ? 0 : vb + 1;
    }
    SBAR();
    pv_four(o, vb0 + vb * SHM_V, pa);
    VMWAIT();
    if (wid < 4) __syncthreads();
#pragma unroll
    for (int qb = 0; qb < 2; ++qb) {
        if (hi == 0) li_l[r32] = l_reg[qb]; asm volatile("s_waitcnt lgkmcnt(0)" ::: "memory");
        const int rowb = wid * 64 + qb * 32;
        bf16_t* Ow = (bf16_t*)(const_cast<unsigned char*>(wsb) + d.o_off) + (unsigned)rowb * 1024u; float* ssw = (float*)(const_cast<unsigned char*>(wsb) + d.ss_off) + rowb * 16;
        if (rowb < d.nrows) {
#pragma unroll
            for (int r = 0; r < 16; ++r) { const int orow = crow(r, hi); const float rl = __builtin_amdgcn_rcpf(li_l[orow]);
                const float v0 = o[qb][0][r] * rl, v1 = o[qb][1][r] * rl;
                Ow[orow * 1024 + r32] = f2bf(v0); Ow[orow * 1024 + 32 + r32] = f2bf(v1);
                float s2 = v0 * v0 + v1 * v1;
                s2 += __shfl_xor(s2, 1); s2 += __shfl_xor(s2, 2); s2 += __shfl_xor(s2, 4); s2 += __shfl_xor(s2, 8); s2 += __shfl_xor(s2, 16);
                if (r32 == 0) ssw[orow * 16] = s2; } }
        asm volatile("s_waitcnt lgkmcnt(0)" ::: "memory");
    }
    __syncthreads();
#undef TOKB
#undef TVALID
#undef KLOAD
#undef VLOAD
#undef KWRITE
#undef VWRITE
#undef VMWAIT
#undef PK4
}

constexpr int MLA_RING = 4, MLA_K_OFF = MLA_RING * SHM_V, MLA_WS_OFF = MLA_RING * (SHM_V + SHM_K);
__device__ __forceinline__ void mla_unit(const AttnDesc d, const unsigned char* wsb, char* lds) {
    constexpr int ND = 6;
    constexpr unsigned LDQ = 384, LDKA = 256, LDKB = 32, LDV = 256;
    constexpr float THRL = 8.f * 1.4426950408889634f;
    const int tid = opaque_tid(), wid = __builtin_amdgcn_readfirstlane(tid >> 6), lane = tid & 63, r32 = lane & 31, hi = lane >> 5;
    char* V_lds = lds; char* K_lds = lds + MLA_K_OFF;
    LAS unsigned char* ldsl_ = (LAS unsigned char*)lds;
    float* wsf = (float*)(lds + MLA_WS_OFF) + wid * 64; float* li_l = wsf; float* al_l = wsf + 32;
    float m_reg[2] = {0.f, 0.f}, l_reg[2] = {0.f, 0.f}; f32x16 o[2][2]; bf16x8 qr[2][ND];
#pragma unroll
    for (int qb = 0; qb < 2; ++qb) { o[qb][0] = f32x16{}; o[qb][1] = f32x16{};
        const bf16_t* Qw = (const bf16_t*)(wsb + d.q_off) + (unsigned)(wid * 64 + qb * 32 + r32) * LDQ + hi * 8;
#pragma unroll
        for (int d0 = 0; d0 < ND; ++d0) qr[qb][d0] = *(const bf16x8*)(Qw + d0 * 16); }
    const int vb0 = (int)(uintptr_t)V_lds + v_rd_base(lane), kbase = (int)(uintptr_t)K_lds;
    int koff[ND];
#pragma unroll
    for (int d0 = 0; d0 < ND; ++d0) koff[d0] = KSWZ(r32, d0 * 32 + hi * 16);
    const int NT = d.NT;
    unsigned kstr[2], kcol[2];
#pragma unroll
    for (int pi = 0; pi < 2; ++pi) { const int row = 8 * wid + 4 * pi + (lane >> 4), c = (lane & 15) ^ (row & 15);
        if (c < 8) { kstr[pi] = LDKA * 2u; kcol[pi] = d.ka_off + (unsigned)c * 16u; }
        else if (c < 12) { kstr[pi] = LDKB * 2u; kcol[pi] = d.kb_off + (unsigned)(c - 8) * 16u; }
        else { kstr[pi] = LDKA * 2u; kcol[pi] = d.ka_off + (unsigned)(c & 7) * 16u; }
        kcol[pi] += (unsigned)row * kstr[pi]; }
    unsigned vcol;
    { const int kk = 8 * wid + ((lane >> 2) & 7), key = (kk & ~0xC) | ((kk & 4) << 1) | ((kk & 8) >> 1), c = 32 * (lane >> 5) + 8 * (lane & 3);
      vcol = d.v_off + (unsigned)key * (LDV * 2u) + (unsigned)c * 2u; }
#define TOKB(t) (((t) < d.n_first) ? d.first_base + 64 * (t) : d.second_base + 64 * min((t) - d.n_first, d.clampmax))
#define K_DMA(t) do { const unsigned tb_ = (unsigned)TOKB(min((t), NT - 1)); const int sl_ = (t) & (MLA_RING - 1); \
        __builtin_amdgcn_global_load_lds((const unsigned*)(wsb + (tb_ * kstr[0] + kcol[0])), (LAS unsigned*)(ldsl_ + MLA_K_OFF + sl_ * SHM_K + wid * 2048), 16, 0, 0); \
        __builtin_amdgcn_global_load_lds((const unsigned*)(wsb + (tb_ * kstr[1] + kcol[1])), (LAS unsigned*)(ldsl_ + MLA_K_OFF + sl_ * SHM_K + wid * 2048 + 1024), 16, 0, 0); } while (0)
#define V_DMA(t) do { const unsigned tb_ = (unsigned)TOKB(min((t), NT - 1)); const int sl_ = (t) & (MLA_RING - 1); \
        __builtin_amdgcn_global_load_lds((const unsigned*)(wsb + (tb_ * (LDV * 2u) + vcol)), (LAS unsigned*)(ldsl_ + sl_ * SHM_V + wid * 2048), 16, 0, 0); } while (0)
#define MBAR() do { asm volatile("s_waitcnt lgkmcnt(0)" ::: "memory"); __builtin_amdgcn_s_barrier(); asm volatile("" ::: "memory"); } while (0)
#define PK4(P, BASE, OUT) do { unsigned a0 = pk2(P[BASE + 0], P[BASE + 1]), a1 = pk2(P[BASE + 2], P[BASE + 3]);   \
    unsigned b0 = pk2(P[BASE + 4], P[BASE + 5]), b1 = pk2(P[BASE + 6], P[BASE + 7]);                              \
    auto r0 = __builtin_amdgcn_permlane32_swap(a0, b0, false, false); auto r1 = __builtin_amdgcn_permlane32_swap(a1, b1, false, false); \
    u32x4 w = {r0[0], r1[0], r0[1], r1[1]}; OUT = __builtin_bit_cast(bf16x8, w); } while (0)
    f32x16 p[2][2]; bf16x8 pa[2][4];
    asm volatile("s_waitcnt vmcnt(0)" ::: "memory");
    K_DMA(0); V_DMA(0); K_DMA(1); V_DMA(1); K_DMA(2);
    asm volatile("s_waitcnt vmcnt(0)" ::: "memory");
    MBAR();
    if (wid >= 4) MBAR();
    int kb = 0, vb = MLA_RING - 1;
    for (int j = 0; j < NT; ++j) {
        SBAR(); __builtin_amdgcn_s_setprio(1);
        { const int va = vb0 + vb * SHM_V, ka = kbase + kb * SHM_K;
          bf16x8 kf[3][2];
#define TRD(dst, db, ks, half) asm volatile("ds_read_b64_tr_b16 %0, %1 offset:%2" : "=&v"(dst) : "v"(va), "i"(v_rd_off(db, ks, half)) : "memory")
#define VRD4(ks) do { TRD(vl[ks][0][0], 0, ks, 0); TRD(vl[ks][0][1], 0, ks, 1); TRD(vl[ks][1][0], 1, ks, 0); TRD(vl[ks][1][1], 1, ks, 1); } while (0)
#define KRD2(slot, d0) do { asm volatile("ds_read_b128 %0, %1" : "=&v"(kf[slot][0]) : "v"(ka + koff[d0]) : "memory"); \
                            asm volatile("ds_read_b128 %0, %1 offset:8192" : "=&v"(kf[slot][1]) : "v"(ka + koff[d0]) : "memory"); } while (0)
#define LGKM(n) do { asm volatile("s_waitcnt lgkmcnt(" #n ")" ::: "memory"); SBAR(); } while (0)
#define PK(L, H) (bf16x8){L[0], L[1], L[2], L[3], H[0], H[1], H[2], H[3]}
#define PVSTEP(k) do { const bf16x8 f0_ = PK(vl[k][0][0], vl[k][0][1]), f1_ = PK(vl[k][1][0], vl[k][1][1]); \
    o[0][0] = __builtin_amdgcn_mfma_f32_32x32x16_bf16(pa[0][k], f0_, o[0][0], 0, 0, 0); o[1][0] = __builtin_amdgcn_mfma_f32_32x32x16_bf16(pa[1][k], f0_, o[1][0], 0, 0, 0); \
    o[0][1] = __builtin_amdgcn_mfma_f32_32x32x16_bf16(pa[0][k], f1_, o[0][1], 0, 0, 0); o[1][1] = __builtin_amdgcn_mfma_f32_32x32x16_bf16(pa[1][k], f1_, o[1][1], 0, 0, 0); } while (0)
          if (j > 0) {
              s16x4 vl[4][2][2];
              VRD4(0); VRD4(1); VRD4(2);
              LGKM(8); PVSTEP(0); SBAR();
              VRD4(3);
              LGKM(8); PVSTEP(1); SBAR();
              KRD2(0, 0);
              LGKM(6); PVSTEP(2); SBAR();
              KRD2(1, 1);
              LGKM(4); PVSTEP(3);
              SBAR();
              KRD2(2, 2);
          } else {
              KRD2(0, 0); KRD2(1, 1); KRD2(2, 2);
          }
#pragma unroll
          for (int d0 = 0; d0 < ND; ++d0) {
              if (d0 + 2 < ND) LGKM(4); else if (d0 + 1 < ND) LGKM(2); else LGKM(0);
              const bf16x8 b0 = kf[d0 % 3][0], b1 = kf[d0 % 3][1];
              if (d0 == 0) { const f32x16 z16 = f32x16{};
                  p[0][0] = __builtin_amdgcn_mfma_f32_32x32x16_bf16(b0, qr[0][0], z16, 0, 0, 0); p[1][0] = __builtin_amdgcn_mfma_f32_32x32x16_bf16(b0, qr[1][0], z16, 0, 0, 0);
                  p[0][1] = __builtin_amdgcn_mfma_f32_32x32x16_bf16(b1, qr[0][0], z16, 0, 0, 0); p[1][1] = __builtin_amdgcn_mfma_f32_32x32x16_bf16(b1, qr[1][0], z16, 0, 0, 0);
              } else {
                  p[0][0] = __builtin_amdgcn_mfma_f32_32x32x16_bf16(b0, qr[0][d0], p[0][0], 0, 0, 0); p[1][0] = __builtin_amdgcn_mfma_f32_32x32x16_bf16(b0, qr[1][d0], p[1][0], 0, 0, 0);
                  p[0][1] = __builtin_amdgcn_mfma_f32_32x32x16_bf16(b1, qr[0][d0], p[0][1], 0, 0, 0); p[1][1] = __builtin_amdgcn_mfma_f32_32x32x16_bf16(b1, qr[1][d0], p[1][1], 0, 0, 0);
              }
              SBAR();
              if (d0 + 3 < ND) KRD2(d0 % 3, d0 + 3);
          }
#undef TRD
#undef VRD4
#undef KRD2
#undef LGKM
#undef PK
#undef PVSTEP
        }
        __builtin_amdgcn_s_setprio(0);
        asm volatile("s_waitcnt vmcnt(3)" ::: "memory");
        MBAR();
        K_DMA(j + 3); V_DMA(j + 2);
#pragma unroll
        for (int qb = 0; qb < 2; ++qb) {
            float pmax = p[qb][0][0];
#pragma unroll
            for (int r = 1; r < 16; ++r) pmax = fmaxf(pmax, p[qb][0][r]);
#pragma unroll
            for (int r = 0; r < 16; ++r) pmax = fmaxf(pmax, p[qb][1][r]);
            { auto rr = __builtin_amdgcn_permlane32_swap(__float_as_uint(pmax), __float_as_uint(pmax), false, false);
              pmax = fmaxf(__uint_as_float(rr[0]), __uint_as_float(rr[1])); }
            float alpha = 1.f; pmax -= m_reg[qb];
            if (__builtin_expect(!__all(pmax <= THRL), 0)) {
                const float dl = fmaxf(pmax, 0.f); m_reg[qb] += dl; alpha = __builtin_amdgcn_exp2f(-dl);
                if (hi == 0) al_l[r32] = alpha; asm volatile("s_waitcnt lgkmcnt(0)" ::: "memory");
#pragma unroll
                for (int dd = 0; dd < 2; ++dd)
#pragma unroll
                    for (int r = 0; r < 16; ++r) o[qb][dd][r] *= al_l[crow(r, hi)]; }
            if (__builtin_expect(!__all(m_reg[qb] == 0.f), 0)) {
#pragma unroll
                for (int r = 0; r < 16; ++r) { p[qb][0][r] -= m_reg[qb]; p[qb][1][r] -= m_reg[qb]; } }
            float ps0 = 0.f, ps1 = 0.f;
#pragma unroll
            for (int r = 0; r < 16; ++r) { p[qb][0][r] = __builtin_amdgcn_exp2f(p[qb][0][r]); ps0 += p[qb][0][r]; }
#pragma unroll
            for (int r = 0; r < 16; ++r) { p[qb][1][r] = __builtin_amdgcn_exp2f(p[qb][1][r]); ps1 += p[qb][1][r]; }
            float ps = ps0 + ps1;
            { auto rr = __builtin_amdgcn_permlane32_swap(__float_as_uint(ps), __float_as_uint(ps), false, false);
              ps = __uint_as_float(rr[0]) + __uint_as_float(rr[1]); }
            l_reg[qb] = l_reg[qb] * alpha + ps;
            PK4(p[qb][0], 0, pa[qb][0]); PK4(p[qb][0], 8, pa[qb][1]); PK4(p[qb][1], 0, pa[qb][2]); PK4(p[qb][1], 8, pa[qb][3]);
        }
        MBAR();
        kb = (kb + 1) & (MLA_RING - 1); vb = (vb + 1) & (MLA_RING - 1);
    }
    SBAR();
    pv_four(o, vb0 + vb * SHM_V, pa);
    asm volatile("s_waitcnt vmcnt(0)" ::: "memory");
    if (wid < 4) MBAR();
#pragma unroll
    for (int qb = 0; qb < 2; ++qb) {
        if (hi == 0) li_l[r32] = l_reg[qb]; asm volatile("s_waitcnt lgkmcnt(0)" ::: "memory");
        const int rowb = wid * 64 + qb * 32;
        bf16_t* Ow = (bf16_t*)(const_cast<unsigned char*>(wsb) + d.o_off) + (unsigned)rowb * 1024u; float* ssw = (float*)(const_cast<unsigned char*>(wsb) + d.ss_off) + rowb * 16;
        if (rowb < d.nrows) {
#pragma unroll
            for (int r = 0; r < 16; ++r) { const int orow = crow(r, hi); const float rl = __builtin_amdgcn_rcpf(li_l[orow]);
                const float v0 = o[qb][0][r] * rl, v1 = o[qb][1][r] * rl;
                Ow[orow * 1024 + r32] = f2bf(v0); Ow[orow * 1024 + 32 + r32] = f2bf(v1);
                float s2 = v0 * v0 + v1 * v1;
                s2 += __shfl_xor(s2, 1); s2 += __shfl_xor(s2, 2); s2 += __shfl_xor(s2, 4); s2 += __shfl_xor(s2, 8); s2 += __shfl_xor(s2, 16);
                if (r32 == 0) ssw[orow * 16] = s2; } }
        asm volatile("s_waitcnt lgkmcnt(0)" ::: "memory");
    }
    __syncthreads();
#undef TOKB
#undef K_DMA
#undef V_DMA
#undef MBAR
#undef PK4
}

struct AttnDesc1 {
    unsigned q_off;
    unsigned ka_off, kb_off, v_off;
    unsigned o_off, ss_off;
    int first_base, n_first, second_base, clampmax, NT;
    int qy0, R0;
};
constexpr int ATT1_WS_OFF = 2 * SHM_V + 2 * SHM_K, ATT1_BIAS_OFF = ATT1_WS_OFF + 8 * 64 * 4;

template <int DQK, bool NA>
__device__ __forceinline__ void attn_unit_v1(const AttnDesc1 d, const unsigned char* wsb, char* lds) {
    constexpr int ND = DQK / 16;
    constexpr unsigned LDQ = NA ? DINP : 384, LDKA = NA ? DINP : 256, LDKB = NA ? DINP : 32, LDV = NA ? DINP : 256;
    const float C = 1.0f;
    const float THRL1 = 8.f * 1.4426950408889634f;
    const int tid = opaque_tid(), wid = tid >> 6, lane = tid & 63, r32 = lane & 31, hi = lane >> 5;
    bf16_t* V_lds = (bf16_t*)lds; bf16_t* K_lds = (bf16_t*)(lds + 2 * SHM_V);
    float* wsf = (float*)(lds + ATT1_WS_OFF) + wid * 64; float* li_l = wsf; float* al_l = wsf + 32;
    const float* bias = (const float*)(lds + ATT1_BIAS_OFF);
    float m_reg = -1e30f, l_reg = 0; f32x16 o[2]; o[0] = f32x16{}; o[1] = f32x16{}; bf16x8 qr[ND];
    { const bf16_t* Qw = (const bf16_t*)(wsb + d.q_off) + (unsigned)(wid * 32 + r32) * LDQ + hi * 8;
#pragma unroll
      for (int d0 = 0; d0 < ND; ++d0) qr[d0] = *(const bf16x8*)(Qw + d0 * 16); }
    const int sr = NA ? (tid >> 3) : (tid >> 4), sc = NA ? (tid & 7) * 8 : (tid & 15) * 8, vst0 = v_st(sr, sc), vst1 = v_st(32 + sr, sc);
    const int vb0 = (int)(uintptr_t)V_lds + v_rd_base(lane);
    const unsigned krow = ((sc < 64) ? LDKA : LDKB) * 2u, kcol = (sc < 64) ? d.ka_off + sc * 2u : d.kb_off + ((sc - 64) & 31) * 2u;
    const unsigned vrow = LDV * 2u, vcol = d.v_off + (sc & 63) * 2u;
    const int qy = d.qy0 + (wid >> 1), qx = 32 * (wid & 1) + r32;
    const int rs = min(max(qy - 4, 0), 120), cs = min(max(qx - 8, 0), 48);
    bf16x8 vs0, vs1, ks0, ks1;
#define TOKB(t) (((t) < d.n_first) ? d.first_base + 64 * (t) : d.second_base + 64 * min((t) - d.n_first, d.clampmax))
#define SLOAD(t) do { const unsigned t0_ = (unsigned)(TOKB(t) + sr); \
    vs0 = *(const bf16x8*)(wsb + (t0_ * vrow + vcol)); ks0 = *(const bf16x8*)(wsb + (t0_ * krow + kcol)); \
    if constexpr (!NA) { vs1 = *(const bf16x8*)(wsb + ((t0_ + 32u) * vrow + vcol)); ks1 = *(const bf16x8*)(wsb + ((t0_ + 32u) * krow + kcol)); } } while (0)
#define SWRITE(b) do { if constexpr (NA) { *(bf16x8*)((char*)V_lds + (b) * SHM_V + vst0) = vs0; *(bf16x8*)((char*)K_lds + (b) * SHM_K + KSWZ(sr, sc * 2)) = ks0; } else { if (sc < 64) { *(bf16x8*)((char*)V_lds + (b) * SHM_V + vst0) = vs0; *(bf16x8*)((char*)V_lds + (b) * SHM_V + vst1) = vs1; } \
    if (sc < DQK) { const int kc = sc * 2; *(bf16x8*)((char*)K_lds + (b) * SHM_K + KSWZ(sr, kc)) = ks0; *(bf16x8*)((char*)K_lds + (b) * SHM_K + KSWZ(32 + sr, kc)) = ks1; } } } while (0)
#define SWAIT() asm volatile("s_waitcnt vmcnt(0)" ::: "memory")
#define RESC(a) do { if (__any((a) < 1.f)) { if (hi == 0) al_l[r32] = (a); asm volatile("s_waitcnt lgkmcnt(0)" ::: "memory"); \
    _Pragma("unroll") for (int dd = 0; dd < 2; ++dd) _Pragma("unroll") for (int r = 0; r < 16; ++r) o[dd][r] *= al_l[crow(r, hi)]; } } while (0)
#define QKT(p0, p1, Ks) do { p0 = f32x16{}; p1 = f32x16{}; \
    _Pragma("unroll") for (int d0 = 0; d0 < ND; ++d0) { const int cb = (d0 * 16 + hi * 8) * 2; \
        const bf16x8 b0 = *(const bf16x8*)((const char*)(Ks) + KSWZ(r32, cb)); \
        const bf16x8 b1 = *(const bf16x8*)((const char*)(Ks) + KSWZ(32 + r32, cb)); \
        p0 = __builtin_amdgcn_mfma_f32_32x32x16_bf16(b0, qr[d0], p0, 0, 0, 0); \
        p1 = __builtin_amdgcn_mfma_f32_32x32x16_bf16(b1, qr[d0], p1, 0, 0, 0); } } while (0)
#define NAMOD(p0, p1, t) do { if constexpr (NA) { if ((t) >= d.n_first) { \
        const int R_ = d.R0 + ((t) - d.n_first); const bool tv_ = (R_ >= rs) && (R_ < rs + 8); \
        const float* brow_ = bias + min(max(R_ - qy + 7, 0), 14) * 128 + (63 - qx); \
        _Pragma("unroll") for (int r = 0; r < 16; ++r) { \
            const int kx0 = crow(r, hi), kx1 = kx0 + 32; \
            const bool ok0 = tv_ && ((unsigned)(kx0 - cs) < 16u), ok1 = tv_ && ((unsigned)(kx1 - cs) < 16u); \
            p0[r] = ok0 ? p0[r] + brow_[kx0] : -INFINITY; \
            p1[r] = ok1 ? p1[r] + brow_[kx1] : -INFINITY; \
            if ((r & 3) == 3) asm volatile("" ::: "memory"); } } } } while (0)
#define PARTIALSM(p0, p1, mn, alpha) do { \
    float pmax = p0[0]; \
    _Pragma("unroll") for (int r = 1; r < 16; ++r) pmax = fmaxf(pmax, p0[r]); \
    _Pragma("unroll") for (int r = 0; r < 16; ++r) pmax = fmaxf(pmax, p1[r]); \
    { auto rr = __builtin_amdgcn_permlane32_swap(__float_as_uint(pmax), __float_as_uint(pmax), false, false); \
      pmax = fmaxf(__uint_as_float(rr[0]), __uint_as_float(rr[1])); } \
    if (__builtin_expect(__all(pmax - m_reg <= THRL1), 1)) { mn = m_reg; alpha = 1.f; } \
    else { mn = fmaxf(m_reg, pmax); alpha = __builtin_amdgcn_exp2f((m_reg - mn) * C); m_reg = mn; } \
    const float mnC = -mn * C; \
    _Pragma("unroll") for (int r = 0; r < 16; ++r) p0[r] = fmaf(p0[r], C, mnC); \
    _Pragma("unroll") for (int r = 0; r < 16; ++r) p1[r] = fmaf(p1[r], C, mnC); \
    _Pragma("unroll") for (int r = 0; r < 16; ++r) p0[r] = __builtin_amdgcn_exp2f(p0[r]); } while (0)
#define PK4(P, BASE, OUT) do { unsigned a0 = pk2(P[BASE + 0], P[BASE + 1]), a1 = pk2(P[BASE + 2], P[BASE + 3]);   \
    unsigned b0 = pk2(P[BASE + 4], P[BASE + 5]), b1 = pk2(P[BASE + 6], P[BASE + 7]);                              \
    auto r0 = __builtin_amdgcn_permlane32_swap(a0, b0, false, false); auto r1 = __builtin_amdgcn_permlane32_swap(a1, b1, false, false); \
    u32x4 w = {r0[0], r1[0], r0[1], r1[1]}; OUT = __builtin_bit_cast(bf16x8, w); } while (0)
#define FINISHSM(p0, p1, alpha) do { \
    _Pragma("unroll") for (int r = 0; r < 16; ++r) p1[r] = __builtin_amdgcn_exp2f(p1[r]); \
    float ps = 0; \
    _Pragma("unroll") for (int r = 0; r < 16; ++r) ps += p0[r]; \
    _Pragma("unroll") for (int r = 0; r < 16; ++r) ps += p1[r]; \
    { auto rr = __builtin_amdgcn_permlane32_swap(__float_as_uint(ps), __float_as_uint(ps), false, false); \
      ps = __uint_as_float(rr[0]) + __uint_as_float(rr[1]); } \
    l_reg = l_reg * alpha + ps; \
    PK4(p0, 0, pa0); PK4(p0, 8, pa1); PK4(p1, 0, pa2); PK4(p1, 8, pa3); } while (0)
#define PV2(vb) do { pv_one<0>(o[0], (vb), pa0, pa1, pa2, pa3); pv_one<1>(o[1], (vb), pa0, pa1, pa2, pa3); } while (0)

    f32x16 pA0, pA1, pB0, pB1; float mnA, mnB, alA, alB; bf16x8 pa0, pa1, pa2, pa3; const int NT = d.NT;
    const bf16_t* K1_lds = (const bf16_t*)((const char*)K_lds + SHM_K);
    SLOAD(0); SWAIT(); SWRITE(0); __syncthreads();
    QKT(pA0, pA1, K_lds); NAMOD(pA0, pA1, 0); PARTIALSM(pA0, pA1, mnA, alA);
    SLOAD(1); SWAIT(); SWRITE(1); __syncthreads();
    for (int j = 1; j + 1 < NT; j += 2) {
        SBAR(); QKT(pB0, pB1, K1_lds); NAMOD(pB0, pB1, j);
        FINISHSM(pA0, pA1, alA); SBAR();
        SLOAD(j + 1); SBAR();
        PV2(vb0); PARTIALSM(pB0, pB1, mnB, alB);
        __syncthreads(); SWAIT(); SWRITE(0);
        RESC(alB); __syncthreads();
        SBAR(); QKT(pA0, pA1, K_lds); NAMOD(pA0, pA1, j + 1);
        FINISHSM(pB0, pB1, alB); SBAR();
        SLOAD(j + 2); SBAR();
        PV2(vb0 + SHM_V); PARTIALSM(pA0, pA1, mnA, alA);
        __syncthreads(); SWAIT(); SWRITE(1);
        RESC(alA); __syncthreads();
    }
    SBAR(); QKT(pB0, pB1, K1_lds); NAMOD(pB0, pB1, NT - 1);
    FINISHSM(pA0, pA1, alA); SBAR();
    PV2(vb0); PARTIALSM(pB0, pB1, mnB, alB);
    __syncthreads(); RESC(alB);
    FINISHSM(pB0, pB1, alB); SBAR();
    PV2(vb0 + SHM_V);
    if (hi == 0) li_l[r32] = l_reg; asm volatile("s_waitcnt lgkmcnt(0)" ::: "memory");
    bf16_t* Ow = (bf16_t*)(const_cast<unsigned char*>(wsb) + d.o_off) + (unsigned)(wid * 32) * 1024u; float* ssw = (float*)(const_cast<unsigned char*>(wsb) + d.ss_off) + (wid * 32) * 16;
#pragma unroll
    for (int r = 0; r < 16; ++r) { const int orow = crow(r, hi); const float rl = __builtin_amdgcn_rcpf(li_l[orow]);
        const float v0 = o[0][r] * rl, v1 = o[1][r] * rl;
        Ow[orow * 1024 + r32] = f2bf(v0); Ow[orow * 1024 + 32 + r32] = f2bf(v1);
        float s2 = v0 * v0 + v1 * v1;
        s2 += __shfl_xor(s2, 1); s2 += __shfl_xor(s2, 2); s2 += __shfl_xor(s2, 4); s2 += __shfl_xor(s2, 8); s2 += __shfl_xor(s2, 16);
        if (r32 == 0) ssw[orow * 16] = s2; }
    __syncthreads();
#undef TOKB
#undef SLOAD
#undef SWRITE
#undef SWAIT
#undef RESC
#undef QKT
#undef NAMOD
#undef PARTIALSM
#undef PK4
#undef FINISHSM
#undef PV2
}

struct NaDesc {
    unsigned q_off, k_off, v_off, o_off, ss_off;
    int ctx_base;
    int row_base, R0, nrows;
    int qy0;
};
constexpr int NA_KOFF = 0, NA_VOFF = 32768, NA_BIAS_OFF = 65536;
struct NaChain { bf16x8 qf[2]; f32x4 o[4]; float m, l; };
template <bool MASKED>
__device__ __forceinline__ void na_softmax(NaChain& C, f32x4& s0, f32x4& s1, const float* br, int kb0, int g, int cs, bf16x8& pf, float& al) {
    if constexpr (MASKED) {
#pragma unroll
        for (int r = 0; r < 4; ++r) { const int kx0 = kb0 + 4 * g + r, kx1 = kx0 + 16; const float b0_ = br[kx0], b1_ = br[kx1];
            s0[r] = ((unsigned)(kx0 - cs) < 16u) ? s0[r] + b0_ : -INFINITY; s1[r] = ((unsigned)(kx1 - cs) < 16u) ? s1[r] + b1_ : -INFINITY; } }
    float pm = fmaxf(fmaxf(fmaxf(s0[0], s0[1]), fmaxf(s0[2], s0[3])), fmaxf(fmaxf(s1[0], s1[1]), fmaxf(s1[2], s1[3])));
    pm = fmaxf(pm, xchg16(pm)); pm = fmaxf(pm, xchg32(pm));
    const float mn = fmaxf(C.m, pm); al = __builtin_amdgcn_exp2f(C.m - mn); C.m = mn;
    float ps = 0.f;
#pragma unroll
    for (int r = 0; r < 4; ++r) { s0[r] = __builtin_amdgcn_exp2f(s0[r] - mn); s1[r] = __builtin_amdgcn_exp2f(s1[r] - mn); ps += s0[r] + s1[r]; }
    C.l = C.l * al + ps;
    u32x4 pw; pw.x = pk2(s0[0], s0[1]); pw.y = pk2(s0[2], s0[3]); pw.z = pk2(s1[0], s1[1]); pw.w = pk2(s1[2], s1[3]);
    pf = __builtin_bit_cast(bf16x8, pw);
}
template <bool MASKED, bool DOA, bool DOB>
__device__ __forceinline__ void na_step(NaChain& A, NaChain& B, const char* Kt, const char* Vt, int kb0, const float* brA, const float* brB, int q, int g, int cs) {
    f32x4 sA0 = (f32x4){0.f, 0.f, 0.f, 0.f}, sA1 = sA0, sB0 = sA0, sB1 = sA0;
#pragma unroll
    for (int s = 0; s < 2; ++s) {
        const int r0 = kb0 + q, r1 = r0 + 16;
        const bf16x8 a0 = *(const bf16x8*)(Kt + r0 * 128 + (((4 * s + g) ^ (r0 & 7)) << 4));
        const bf16x8 a1 = *(const bf16x8*)(Kt + r1 * 128 + (((4 * s + g) ^ (r1 & 7)) << 4));
        if constexpr (DOA) { sA0 = __builtin_amdgcn_mfma_f32_16x16x32_bf16(a0, A.qf[s], sA0, 0, 0, 0); sA1 = __builtin_amdgcn_mfma_f32_16x16x32_bf16(a1, A.qf[s], sA1, 0, 0, 0); }
        if constexpr (DOB) { sB0 = __builtin_amdgcn_mfma_f32_16x16x32_bf16(a0, B.qf[s], sB0, 0, 0, 0); sB1 = __builtin_amdgcn_mfma_f32_16x16x32_bf16(a1, B.qf[s], sB1, 0, 0, 0); } }
    bf16x8 pfA, pfB; float alA = 1.f, alB = 1.f;
    if constexpr (DOA) na_softmax<MASKED>(A, sA0, sA1, brA, kb0, g, cs, pfA, alA);
    if constexpr (DOB) na_softmax<MASKED>(B, sB0, sB1, brB, kb0, g, cs, pfB, alB);
    s16x4 t0_[4], t1_[4];
#pragma unroll
    for (int c = 0; c < 4; ++c) {
        const int k0 = kb0 + 4 * g + (q >> 2), k1 = k0 + 16; const int c16 = 2 * c + ((q & 3) >> 1);
        const int ad0 = (int)(uintptr_t)(Vt + k0 * 128 + ((c16 ^ (k0 & 7)) << 4) + (q & 1) * 8), ad1 = (int)(uintptr_t)(Vt + k1 * 128 + ((c16 ^ (k1 & 7)) << 4) + (q & 1) * 8);
        t0_[c] = tr_read<0>(ad0); t1_[c] = tr_read<0>(ad1); }
    asm volatile("s_waitcnt lgkmcnt(0)" ::: "memory"); SBAR();
#pragma unroll
    for (int c = 0; c < 4; ++c) {
        const bf16x8 vf = (bf16x8){t0_[c][0], t0_[c][1], t0_[c][2], t0_[c][3], t1_[c][0], t1_[c][1], t1_[c][2], t1_[c][3]};
        if constexpr (DOA) { A.o[c] = A.o[c] * alA; A.o[c] = __builtin_amdgcn_mfma_f32_16x16x32_bf16(vf, pfA, A.o[c], 0, 0, 0); }
        if constexpr (DOB) { B.o[c] = B.o[c] * alB; B.o[c] = __builtin_amdgcn_mfma_f32_16x16x32_bf16(vf, pfB, B.o[c], 0, 0, 0); } }
}
__device__ __forceinline__ void na_unit(const NaDesc d, const unsigned char* wsb, char* lds) {
    const int tid = opaque_tid(), wid = __builtin_amdgcn_readfirstlane(tid >> 6), lane = tid & 63, q = lane & 15, g = lane >> 4;
    const int seg = wid & 3, qyA = d.qy0 + (wid >> 2), qyB = qyA + 2, qx = 16 * seg + q;
    const int cstart = (seg == 0) ? 0 : (seg == 1 ? 8 : (seg == 2 ? 24 : 32));
    const int rsA = min(max(qyA - 4, 0), 120), rsB = min(max(qyB - 4, 0), 120), cs = min(max(qx - 8, 0), 48);
    const float* bias = (const float*)(lds + NA_BIAS_OFF);
    const unsigned rowA = (unsigned)((wid >> 2) * 64 + seg * 16 + q), rowB = rowA + 128u;
    NaChain A, B;
    { const bf16_t* Qa = (const bf16_t*)(wsb + d.q_off) + rowA * DINP + 8 * g; A.qf[0] = *(const bf16x8*)Qa; A.qf[1] = *(const bf16x8*)(Qa + 32);
      const bf16_t* Qb = (const bf16_t*)(wsb + d.q_off) + rowB * DINP + 8 * g; B.qf[0] = *(const bf16x8*)Qb; B.qf[1] = *(const bf16x8*)(Qb + 32); }
#pragma unroll
    for (int c = 0; c < 4; ++c) { A.o[c] = (f32x4){0.f, 0.f, 0.f, 0.f}; B.o[c] = A.o[c]; }
    A.m = B.m = -1e30f; A.l = B.l = 0.f;
    const int sk = tid >> 3, sp8 = tid & 7;
    const unsigned srcoff = (unsigned)sk * (unsigned)(DINP * 2) + (unsigned)((sp8 ^ (sk & 7)) * 16);
    const int NT = 4 + d.nrows;
    LAS unsigned char* ldsl_ = (LAS unsigned char*)lds;
    const unsigned ldsw = (unsigned)wid * 1024u;
#define NA_TOK(t) (((t) < 4) ? d.ctx_base + 64 * (t) : d.row_base + 64 * ((t) - 4))
#define NA_DMA(t) do { const int tt_ = min((t), NT - 1); const unsigned to_ = (unsigned)NA_TOK(tt_) * (unsigned)(DINP * 2) + srcoff; const int sl_ = (t) & 3; \
        __builtin_amdgcn_global_load_lds((const unsigned*)(wsb + (d.k_off + to_)), (LAS unsigned*)(ldsl_ + NA_KOFF + sl_ * 8192 + ldsw), 16, 0, 0); \
        __builtin_amdgcn_global_load_lds((const unsigned*)(wsb + (d.v_off + to_)), (LAS unsigned*)(ldsl_ + NA_VOFF + sl_ * 8192 + ldsw), 16, 0, 0); } while (0)
    asm volatile("s_waitcnt vmcnt(0)" ::: "memory");
    NA_DMA(0); NA_DMA(1); NA_DMA(2);
    for (int t = 0; t < NT; ++t) {
        asm volatile("s_waitcnt vmcnt(4)" ::: "memory");
        __builtin_amdgcn_s_barrier();
        NA_DMA(t + 3);
        const int buf = t & 3; const char* Kt = lds + NA_KOFF + buf * 8192; const char* Vt = lds + NA_VOFF + buf * 8192;
        if (t < 4) { na_step<false, true, true>(A, B, Kt, Vt, 0, bias, bias, q, g, cs); na_step<false, true, true>(A, B, Kt, Vt, 32, bias, bias, q, g, cs); }
        else { const int R = d.R0 + (t - 4); const bool actA = (R >= rsA && R < rsA + 8), actB = (R >= rsB && R < rsB + 8);
            const float* brA = bias + (R - qyA + 7) * 64 + (31 - qx); const float* brB = bias + (R - qyB + 7) * 64 + (31 - qx);
            if (actA && actB) na_step<true, true, true>(A, B, Kt, Vt, cstart, brA, brB, q, g, cs);
            else if (actA) na_step<true, true, false>(A, B, Kt, Vt, cstart, brA, brB, q, g, cs);
            else if (actB) na_step<true, false, true>(A, B, Kt, Vt, cstart, brA, brB, q, g, cs); }
        asm volatile("s_waitcnt lgkmcnt(0)" ::: "memory");
    }
    asm volatile("s_waitcnt vmcnt(0)" ::: "memory");
    __builtin_amdgcn_s_barrier();
#define NA_EPI(C, ROW) do { float l_ = C.l; l_ += xchg16(l_); l_ += xchg32(l_); const float rl = __builtin_amdgcn_rcpf(l_); \
        bf16_t* Orow = (bf16_t*)(const_cast<unsigned char*>(wsb) + d.o_off) + (ROW) * 1024u + 4 * g; float s2 = 0.f; \
        _Pragma("unroll") for (int c = 0; c < 4; ++c) { const f32x4 v = C.o[c] * rl; s2 += (v[0] * v[0] + v[1] * v[1]) + (v[2] * v[2] + v[3] * v[3]); \
            u32x2 w; w.x = pk2(v[0], v[1]); w.y = pk2(v[2], v[3]); *(u32x2*)(Orow + 16 * c) = w; } \
        s2 += xchg16(s2); s2 += xchg32(s2); \
        if (g == 0) ((float*)(const_cast<unsigned char*>(wsb) + d.ss_off))[(ROW) * 16] = s2; } while (0)
    NA_EPI(A, rowA); NA_EPI(B, rowB);
    __syncthreads();
#undef NA_EPI
#undef NA_TOK
#undef NA_DMA
}

struct Params {
    const float* in[25];
    float* out;
    unsigned char* ws;
    int ph_lo, ph_hi;
};
enum { I_X = 0, I_C, I_CTX, I_CCTX, I_ADAW, I_ADAB, I_N1G, I_N2G, I_WIN, I_NABIAS, I_POOLW, I_POOLS, I_FNOW, I_QNORM, I_WUQ, I_KVNORM, I_WUK, I_WUV, I_GRPN, I_WOUT, I_ROUTER, I_EGATE, I_EUP, I_EDOWN, I_FINAL };
constexpr int NWAVES = 8, NTHR = 512;

__device__ __forceinline__ void tr_item(const float* src, long ld, bf16_t* dst, long dld, LAS float* scr, int lane, float wscale = 1.f) {
    const float* sp = src + (long)(lane >> 5) * ld + (lane & 31); const long sstep = 2 * ld;
    { float tv[32];
#pragma unroll
      for (int i = 0; i < 32; ++i) { tv[i] = *sp; sp += sstep; asm volatile("" : "+v"(sp)); }
#pragma unroll
      for (int i = 0; i < 32; ++i) { const int kk = 2 * i + (lane >> 5); scr[kk * 33 + (lane & 31)] = tv[i] * wscale; } }
    LDS_WAIT(); asm volatile("" ::: "memory");
    const int c = lane & 7;
#pragma unroll
    for (int j = 0; j < 4; ++j) { const int n = (lane >> 3) + 8 * j; const LAS float* s = scr + (8 * c) * 33 + n;
        u32x4 o; o.x = pk2(s[0 * 33], s[1 * 33]); o.y = pk2(s[2 * 33], s[3 * 33]); o.z = pk2(s[4 * 33], s[5 * 33]); o.w = pk2(s[6 * 33], s[7 * 33]);
        *(u32x4*)(dst + (long)n * dld + 8 * c) = o; }
    LDS_WAIT(); asm volatile("" ::: "memory");
}
constexpr int SMI_WIN = 16 * 53, SMI_WUQ = 4 * 12, SMI_WUK = 2 * 8, SMI_WUV = 2 * 8, SMI_POOL = 8, SMI_WOUT = 16 * 32;
constexpr int SMI_TOTAL = SMI_WIN + SMI_WUQ + SMI_WUK + SMI_WUV + SMI_POOL + SMI_WOUT;
__device__ __forceinline__ void small_weight_item(const Params& p, int l, int it, LAS float* scr, int lane) {
    unsigned char* sw = p.ws + WS_SMALLW + (size_t)l * SW_BYTES;
    int r = it;
    if (r < SMI_WIN) { const int kb = r / 53, nb = r % 53; tr_item(p.in[I_WIN] + (size_t)l * 1024 * DIN + (size_t)(64 * kb) * DIN + 32 * nb, DIN, (bf16_t*)(sw + SW_WIN) + (size_t)(32 * nb) * 1024 + 64 * kb, 1024, scr, lane, (32 * nb < 256) ? QSCALE_NA : 1.f); return; } r -= SMI_WIN;
    if (r < SMI_WUQ) { const int kb = r / 12, nb = r % 12; tr_item(p.in[I_WUQ] + (size_t)l * 256 * 384 + (size_t)(64 * kb) * 384 + 32 * nb, 384, (bf16_t*)(sw + SW_WUQ) + (size_t)(32 * nb) * 256 + 64 * kb, 256, scr, lane); return; } r -= SMI_WUQ;
    if (r < SMI_WUK) { const int kb = r / 8, nb = r % 8; tr_item(p.in[I_WUK] + (size_t)l * 128 * 256 + (size_t)(64 * kb) * 256 + 32 * nb, 256, (bf16_t*)(sw + SW_WUKV) + (size_t)(32 * nb) * 256 + 64 * kb, 256, scr, lane); return; } r -= SMI_WUK;
    if (r < SMI_WUV) { const int kb = r / 8, nb = r % 8; tr_item(p.in[I_WUV] + (size_t)l * 128 * 256 + (size_t)(64 * kb) * 256 + 32 * nb, 256, (bf16_t*)(sw + SW_WUKV) + (size_t)(256 + 32 * nb) * 256 + 64 * kb, 256, scr, lane); return; } r -= SMI_WUV;
    if (r < SMI_POOL) { const int g = r >> 1, nb = r & 1; tr_item(p.in[I_POOLW] + (size_t)l * 4 * 4096 + (size_t)g * 4096 + 32 * nb, 64, (bf16_t*)(sw + SW_POOL) + (size_t)(64 * g + 32 * nb) * 256 + 64 * g, 256, scr, lane); return; } r -= SMI_POOL;
    { const int kb = r / 32, nb = r % 32; tr_item(p.in[I_WOUT] + (size_t)l * 1024 * 1024 + (size_t)(64 * kb) * 1024 + 32 * nb, 1024, (bf16_t*)(sw + SW_WOUT) + (size_t)(32 * nb) * 1024 + 64 * kb, 1024, scr, lane); }
}
constexpr int EXI_PER_MAT = 16 * 32, EXI_TOTAL = NE * 3 * EXI_PER_MAT;
__device__ __forceinline__ void expert_weight_item(const Params& p, int l, int it, LAS float* scr, int lane) {
    const int e = it / (3 * EXI_PER_MAT), r0 = it % (3 * EXI_PER_MAT), which = r0 / EXI_PER_MAT, r = r0 % EXI_PER_MAT, kb = r / 32, nb = r % 32, n0 = 32 * nb;
    const size_t eoff = ((size_t)l * NE + e) * 1024 * 1024;
    if (which == 2) { tr_item(p.in[I_EDOWN] + eoff + (size_t)(64 * kb) * 1024 + n0, 1024, (bf16_t*)(p.ws + WS_WD) + (size_t)e * 1024 * 1024 + (size_t)n0 * 1024 + 64 * kb, 1024, scr, lane); return; }
    const float* src = (which == 0 ? p.in[I_EGATE] : p.in[I_EUP]) + eoff + (size_t)(64 * kb) * 1024 + n0;
    const int drow = (n0 >> 7) * 256 + (n0 & 127) + (which == 1 ? 128 : 0);
    tr_item(src, 1024, (bf16_t*)(p.ws + WS_WGU) + (size_t)e * 2048 * 1024 + (size_t)drow * 1024 + 64 * kb, 1024, scr, lane);
}
__device__ __forceinline__ void zero_region(unsigned char* base, int rows, int rowbytes, size_t pitch, int gtid, int GT) {
    const int per = rowbytes / 16; const long total = (long)rows * per;
    for (long i = gtid; i < total; i += GT) { const long r = i / per, c = i % per; *(u32x4*)(base + r * pitch + c * 16) = (u32x4){0u, 0u, 0u, 0u}; }
}

__device__ __forceinline__ void phase_a0(const Params& p, LAS unsigned char* ldsl) {
    const int tid = opaque_tid(), lane = tid & 63, wave = __builtin_amdgcn_readfirstlane(tid >> 6);
    const int G = gridDim.x, gtid = blockIdx.x * NTHR + tid, GT = G * NTHR, gw = blockIdx.x * NWAVES + wave, NGW = G * NWAVES;
    unsigned char* ws = p.ws;
    { float* rc = (float*)(ws + WS_ROPE); float* rs = rc + 1024;
      for (int i = gtid; i < 1024; i += GT) { const int pos = i >> 3, f = i & 7; const float inv = powf(10000.f, -(float)f / 8.f); const float ang = (float)pos * inv; rc[i] = cosf(ang); rs[i] = sinf(ang); }
      f32x2* tw = (f32x2*)(ws + WS_TW8192);
      for (int i = gtid; i < 8192; i += GT) { float s, c; sincospif(2.f * (float)i / 8192.f, &s, &c); tw[i] = (f32x2){c, s}; }
      f32x2* tw2 = (f32x2*)(ws + WS_TW256);
      for (int i = gtid; i < 256; i += GT) { float s, c; sincospif(2.f * (float)i / 256.f, &s, &c); tw2[i] = (f32x2){c, s}; }
      bf16_t* r128 = (bf16_t*)(ws + WS_R128);
      for (int i = gtid; i < 256 * 128; i += GT) { const int row = i >> 7, n1 = i & 127, w = row >> 5, ii = row & 31, k1 = 16 * w + (ii & 15), im = ii >> 4; const int idx = (k1 * n1) & 127;
          float s, c; sincospif(2.f * (float)idx / 128.f, &s, &c); r128[i] = f2bf(im ? -s : c); }
      bf16_t* r64 = (bf16_t*)(ws + WS_R64);
      for (int i = gtid; i < 128 * 128; i += GT) { const int row = i >> 7, kk = i & 127, rb = row >> 5, ii = row & 31, k2 = 16 * rb + (ii & 15), rio = ii >> 4, rii = kk >> 6, n2 = kk & 63; const int idx = (k2 * n2) & 63;
          float s, c; sincospif(2.f * (float)idx / 64.f, &s, &c);
          const float v = (rio == 0) ? (rii == 0 ? c : s) : (rii == 0 ? -s : c); r64[i] = f2bf(v); }
    }
    { LAS float* c64 = (LAS float*)ldsl; LAS float* s64 = c64 + 64;
      if (tid < 64) { float s, c; sincospif(2.f * (float)tid / 64.f, &s, &c); c64[tid] = c; s64[tid] = s; }
      __syncthreads();
      for (int i = gtid; i < 2 * 512 * 256; i += GT) { const int l = i >> 17, kk = (i >> 8) & 511, j = i & 255, ri = kk >> 8, gc = kk & 255, g = gc >> 6, c = gc & 63;
          const float* fw = p.in[I_FNOW] + (size_t)l * 65536 + (size_t)(g * 64) * 256 + j; float a = 0.f;
          for (int m = 0; m < 64; ++m) { const int idx = (c * m) & 63; a += (ri ? s64[idx] : c64[idx]) * fw[(size_t)m * 256]; }
          ((bf16_t*)(ws + WS_SMALLW + (size_t)l * SW_BYTES + SW_WF))[kk * 256 + j] = f2bf(a); }
      __syncthreads();
    }
    for (int l = 0; l < 2; ++l) { unsigned char* sw = ws + WS_SMALLW + (size_t)l * SW_BYTES;
        zero_region(sw + SW_WIN + (size_t)DIN * 1024 * 2, DINP - DIN, 2048, 2048, gtid, GT);
        zero_region(sw + SW_WUQ + (size_t)384 * 256 * 2, 128, 512, 512, gtid, GT);
        zero_region(sw + SW_WUKV + 256, 512, 256, 512, gtid, GT);
        for (int g = 0; g < 4; ++g) for (int g2 = 0; g2 < 4; ++g2) if (g != g2) zero_region(sw + SW_POOL + (size_t)(64 * g) * 512 + 128 * g2, 64, 128, 512, gtid, GT); }
    { LAS float* sv = (LAS float*)(ldsl + 1024); LAS float* red = sv + 5 * 1024;
      for (int i = tid; i < 5 * 1024; i += NTHR) { const int v = i >> 10, k = i & 1023; const float x = (v < 4) ? p.in[I_C][v * 1024 + k] : p.in[I_CCTX][k]; sv[i] = x / (1.f + expf(-x)); }
      __syncthreads();
      float* mods = (float*)(ws + WS_MODS);
      for (int item = blockIdx.x; item < 192; item += G) { const int l = item / 96, j0 = (item % 96) * 64, col = tid & 63, kg = tid >> 6;
          const float* w = p.in[I_ADAW] + (size_t)l * 1024 * 6144 + (size_t)(kg * 128) * 6144 + j0 + col;
          float a0 = 0.f, a1 = 0.f, a2 = 0.f, a3 = 0.f, a4 = 0.f;
#pragma unroll 32
          for (int k = 0; k < 128; ++k) { const float wv = w[(size_t)k * 6144]; const int kk = kg * 128 + k;
              a0 += sv[kk] * wv; a1 += sv[1024 + kk] * wv; a2 += sv[2048 + kk] * wv; a3 += sv[3072 + kk] * wv; a4 += sv[4096 + kk] * wv; }
          red[(kg * 5 + 0) * 64 + col] = a0; red[(kg * 5 + 1) * 64 + col] = a1; red[(kg * 5 + 2) * 64 + col] = a2; red[(kg * 5 + 3) * 64 + col] = a3; red[(kg * 5 + 4) * 64 + col] = a4;
          __syncthreads();
          if (tid < 320) { const int v = tid >> 6; float s = 0.f;
#pragma unroll
              for (int q = 0; q < 8; ++q) s += red[(q * 5 + v) * 64 + col];
              mods[(size_t)(l * 5 + v) * 6144 + j0 + col] = s + p.in[I_ADAB][l * 6144 + j0 + col]; }
          __syncthreads(); }
    }
    { LAS float* scr = (LAS float*)(ldsl + 32768 + wave * 8448);
      unsigned* ctr = (unsigned*)(ws + WS_CTL); volatile LAS unsigned* slot = (volatile LAS unsigned*)(ldsl + MISC_OFF + 128);
      for (;;) { if (tid == 0) *slot = __hip_atomic_fetch_add(ctr, 32u, __ATOMIC_RELAXED, __HIP_MEMORY_SCOPE_AGENT);
          __syncthreads(); const int base = (int)*slot; __syncthreads();
          if (base >= 2 * SMI_TOTAL + EXI_TOTAL) break;
          for (int i = 0; i < 4; ++i) { const int it = base + 8 * i + wave; if (it >= 2 * SMI_TOTAL + EXI_TOTAL) break;
              if (it < SMI_TOTAL) small_weight_item(p, 0, it, scr, lane);
              else if (it < 2 * SMI_TOTAL) small_weight_item(p, 1, it - SMI_TOTAL, scr, lane);
              else expert_weight_item(p, 0, it - 2 * SMI_TOTAL, scr, lane); } } }
}

__device__ __forceinline__ void mod_row_store(const f32x4 (&v)[4], float rstd, const float* g, const float* shift, const float* scale, bf16_t* hrow, int lane) {
#pragma unroll
    for (int j = 0; j < 4; ++j) { const int c = 4 * lane + 256 * j; const f32x4 gg = *(const f32x4*)(g + c), sh = *(const f32x4*)(shift + c), sc = *(const f32x4*)(scale + c);
        const f32x4 h = v[j] * rstd * gg * (sc + 1.f) + sh;
        u32x2 w; w.x = pk2(h[0], h[1]); w.y = pk2(h[2], h[3]); *(u32x2*)(hrow + c) = w; }
}
__device__ __forceinline__ float row_rstd(const f32x4 (&v)[4]) {
    float s = 0.f;
#pragma unroll
    for (int j = 0; j < 4; ++j) s += (v[j][0] * v[j][0] + v[j][1] * v[j][1]) + (v[j][2] * v[j][2] + v[j][3] * v[j][3]);
    return rsqrtf(wave_sum(s) * (1.f / 1024.f) + EPS);
}
__device__ __forceinline__ void load_row_bf16(f32x4 (&v)[4], const bf16_t* r, int lane) {
#pragma unroll
    for (int j = 0; j < 4; ++j) { const u32x2 w = *(const u32x2*)(r + 4 * lane + 256 * j); v[j] = (f32x4){bflo(w.x), bfhi(w.x), bflo(w.y), bfhi(w.y)}; }
}
__device__ __forceinline__ void load_row_f32(f32x4 (&v)[4], const float* r, int lane) {
#pragma unroll
    for (int j = 0; j < 4; ++j) v[j] = *(const f32x4*)(r + 4 * lane + 256 * j);
}
__device__ __forceinline__ void load_res_row(f32x4 (&v)[4], int tok, const bf16_t* xlb, const float* xc, int lane) {
    if (tok < TL) load_row_bf16(v, xlb + (size_t)tok * 1024, lane); else load_row_f32(v, xc + (size_t)(tok - TL) * 1024, lane);
}
struct ModCoef { f32x4 ca[4], cb[4]; };
__device__ __forceinline__ void load_modcoef(ModCoef& m, const float* g, const float* shift, const float* scale, int lane) {
#pragma unroll
    for (int j = 0; j < 4; ++j) { const int c = 4 * lane + 256 * j; m.ca[j] = *(const f32x4*)(g + c) * (*(const f32x4*)(scale + c) + 1.f); m.cb[j] = *(const f32x4*)(shift + c); }
}
__device__ __forceinline__ void mod_row_store2(const f32x4 (&v)[4], float rstd, const ModCoef& m, bf16_t* hrow, int lane) {
#pragma unroll
    for (int j = 0; j < 4; ++j) { const f32x4 h = v[j] * rstd * m.ca[j] + m.cb[j]; u32x2 w; w.x = pk2(h[0], h[1]); w.y = pk2(h[2], h[3]); *(u32x2*)(hrow + 4 * lane + 256 * j) = w; }
}
__device__ __forceinline__ void phase_a1(const Params& p) {
    const int tid_ = opaque_tid(); const int lane = tid_ & 63, gw = blockIdx.x * NWAVES + (tid_ >> 6), NGW = gridDim.x * NWAVES;
    const float* mods = (const float*)(p.ws + WS_MODS); bf16_t* H = (bf16_t*)(p.ws + WS_H);
    ModCoef mc; int curb = -1;
#define A1_LOAD(V, t) do { const float* xr_ = ((t) < TL) ? p.in[I_X] + (size_t)(t) * 1024 : p.in[I_CTX] + (size_t)((t) - TL) * 1024; \
        _Pragma("unroll") for (int j = 0; j < 4; ++j) V[j] = *(const f32x4*)(xr_ + 4 * lane + 256 * j); } while (0)
    int tok = gw; f32x4 v[4], v1[4], v2[4];
    if (tok < TA) A1_LOAD(v, tok);
    if (tok + NGW < TA) A1_LOAD(v1, tok + NGW);
    if (tok + 2 * NGW < TA) A1_LOAD(v2, tok + 2 * NGW);
    while (tok < TA) {
        const int t3 = tok + 3 * NGW; f32x4 v3[4];
        if (t3 < TA) A1_LOAD(v3, t3);
        const int bidx = (tok < TL) ? (tok >> 13) : 4;
        if (bidx != curb) { const float* mb = mods + (size_t)bidx * 6144; load_modcoef(mc, p.in[I_N1G], mb, mb + 1024, lane); curb = bidx; }
        const float rstd = row_rstd(v);
        mod_row_store2(v, rstd, mc, H + (size_t)tok * 1024, lane);
#pragma unroll
        for (int j = 0; j < 4; ++j) { v[j] = v1[j]; v1[j] = v2[j]; v2[j] = v3[j]; }
        tok += NGW;
    }
#undef A1_LOAD
}
__device__ __forceinline__ void prep_token(const Params& p, int l, int tok, int lane) {
    const bf16_t* P = (const bf16_t*)(p.ws + WS_P); const bf16_t* prow = P + (size_t)tok * DINP;
    int t, nn; if (tok < TL) { t = tok & (SEQ - 1); nn = SEQ; } else { t = (tok - TL) & (CTXL - 1); nn = CTXL; }
    const int g = lane >> 4, w = 2 << g, hw = w >> 1;
    const int lo = max(t - hw, 0), hi = min(t + w - hw, nn); const bf16_t* pb = P + (size_t)(tok - t) * DINP + PC_PL + 4 * lane;
    const u32x2 wq = *(const u32x2*)(prow + PC_QC + 4 * lane);
    const unsigned wkv = *(const unsigned*)(prow + PC_KVC + 2 * lane);
    const bf16_t wkr = prow[PC_KR + (lane & 31)];
    const u32x2 own = *(const u32x2*)(pb + (size_t)t * DINP);
    u32x2 xw[16];
#pragma unroll
    for (int j = 0; j < 16; ++j) xw[j] = *(const u32x2*)(pb + (size_t)min(lo + j, hi - 1) * DINP);
    const int dd = lane & 31, pos = (tok < TL) ? ((dd >> 4) ? (t & 63) : (t >> 6)) : 0, f = dd & 7;
    const float rc = ((const float*)(p.ws + WS_ROPE))[pos * 8 + f], rsn = ((const float*)(p.ws + WS_ROPE))[1024 + pos * 8 + f];
    const f32x4 gq = *(const f32x4*)(p.in[I_QNORM] + l * 256 + 4 * lane);
    const f32x2 gkv = *(const f32x2*)(p.in[I_KVNORM] + l * 128 + 2 * lane);
    { const float a0 = bflo(wq.x), a1 = bfhi(wq.x), a2 = bflo(wq.y), a3 = bfhi(wq.y);
      const float rstd = rsqrtf(wave_sum((a0 * a0 + a1 * a1) + (a2 * a2 + a3 * a3)) * (1.f / 256.f) + EPS);
      u32x2 o; o.x = pk2(a0 * rstd * gq[0], a1 * rstd * gq[1]); o.y = pk2(a2 * rstd * gq[2], a3 * rstd * gq[3]);
      *(u32x2*)((bf16_t*)(p.ws + WS_QCN) + (size_t)tok * 256 + 4 * lane) = o; }
    { const float a0 = bflo(wkv), a1 = bfhi(wkv);
      const float rstd = rsqrtf(wave_sum(a0 * a0 + a1 * a1) * (1.f / 128.f) + EPS);
      unsigned* ck = (unsigned*)((bf16_t*)(p.ws + WS_CKV) + (size_t)tok * 256);
      ck[lane] = pk2(a0 * rstd * gkv[0], a1 * rstd * gkv[1]); ck[64 + lane] = 0u; }
    { const float val = bf2f(wkr); const float par = __shfl_xor(val, 8); float o = val;
      if (tok < TL) o = ((dd >> 3) & 1) ? (par * rsn + val * rc) : (val * rc - par * rsn);
      if (lane < 32) ((bf16_t*)(p.ws + WS_KR))[(size_t)tok * 32 + lane] = f2bf(o); }
    { float s0 = 0.f, s1 = 0.f, s2 = 0.f, s3 = 0.f;
#pragma unroll
      for (int j = 0; j < 16; ++j) { const float m = (lo + j < hi) ? 1.f : 0.f; s0 += m * bflo(xw[j].x); s1 += m * bfhi(xw[j].x); s2 += m * bflo(xw[j].y); s3 += m * bfhi(xw[j].y); }
      const float inv = 1.f / (float)(hi - lo);
      u32x2 o; o.x = pk2(s0 * inv - bflo(own.x), s1 * inv - bfhi(own.x)); o.y = pk2(s2 * inv - bflo(own.y), s3 * inv - bfhi(own.y));
      *(u32x2*)((bf16_t*)(p.ws + WS_POOLA) + (size_t)tok * 256 + 4 * lane) = o; }
}
__device__ __forceinline__ void fft1_ctx_item(const Params& p, int item, int lane) {
    const int b = item >> 8, k1 = (item >> 6) & 3, n2 = item & 63;
    const bf16_t* P = (const bf16_t*)(p.ws + WS_P);
    float yr[4] = {0.f, 0.f, 0.f, 0.f}, yi[4] = {0.f, 0.f, 0.f, 0.f};
#pragma unroll
    for (int n1 = 0; n1 < 4; ++n1) { const u32x2 x = *(const u32x2*)(P + (size_t)(TL + b * 256 + 64 * n1 + n2) * DINP + PC_FL + 4 * lane);
        const int q = (n1 * k1) & 3; const float cq = (q == 0) ? 1.f : (q == 2 ? -1.f : 0.f), sq = (q == 1) ? 1.f : (q == 3 ? -1.f : 0.f);
        const float u0 = bflo(x.x), u1 = bfhi(x.x), u2 = bflo(x.y), u3 = bfhi(x.y);
        yr[0] += u0 * cq; yr[1] += u1 * cq; yr[2] += u2 * cq; yr[3] += u3 * cq; yi[0] -= u0 * sq; yi[1] -= u1 * sq; yi[2] -= u2 * sq; yi[3] -= u3 * sq; }
    const f32x2 tw = ((const f32x2*)(p.ws + WS_TW256))[(n2 * k1) & 255]; const float tr = tw.x, ti = -tw.y;
    bf16_t* yp = (bf16_t*)(p.ws + WS_YP) + YP_CTX_OFF + ((size_t)(b * 4 + k1) * 128 + n2) * 256 + 4 * lane;
    u32x2 o; o.x = pk2(yr[0] * tr - yi[0] * ti, yr[1] * tr - yi[1] * ti); o.y = pk2(yr[2] * tr - yi[2] * ti, yr[3] * tr - yi[3] * ti); *(u32x2*)yp = o;
    o.x = pk2(yr[0] * ti + yi[0] * tr, yr[1] * ti + yi[1] * tr); o.y = pk2(yr[2] * ti + yi[2] * tr, yr[3] * ti + yi[3] * tr); *(u32x2*)(yp + 64 * 256) = o;
}
__device__ __forceinline__ void fft1_item(const Params& p, int b, int n2, char* lds) {
    const int tid = opaque_tid(), wid = tid >> 6, lane = tid & 63, r32 = lane & 31, hi = lane >> 5;
    const bf16_t* P = (const bf16_t*)(p.ws + WS_P); bf16_t* YP = (bf16_t*)(p.ws + WS_YP);
    const bf16_t* R128 = (const bf16_t*)(p.ws + WS_R128); const f32x2* TW = (const f32x2*)(p.ws + WS_TW8192);
#pragma unroll
    for (int kt = 0; kt < 2; ++kt)
#pragma unroll
        for (int ct = 0; ct < 2; ++ct) stage_vtile(lds + (kt * 2 + ct) * 16384, P + (size_t)(b * SEQ + 4096 * kt + n2) * DINP + PC_FL + 128 * ct, (long)64 * DINP);
    __syncthreads();
    for (int ct = 0; ct < 2; ++ct) {
        f32x16 od[4]; od[0] = f32x16{}; od[1] = f32x16{}; od[2] = f32x16{}; od[3] = f32x16{};
#pragma unroll
        for (int kt = 0; kt < 2; ++kt) {
            const bf16_t* ar = R128 + (size_t)(32 * wid + r32) * 128 + 64 * kt + 8 * hi;
            const bf16x8 pa0 = *(const bf16x8*)(ar), pa1 = *(const bf16x8*)(ar + 16), pa2 = *(const bf16x8*)(ar + 32), pa3 = *(const bf16x8*)(ar + 48);
            const int vb = (int)(uintptr_t)(lds + (kt * 2 + ct) * 16384) + v_rd_base(lane);
            pv_one<0>(od[0], vb, pa0, pa1, pa2, pa3); pv_one<1>(od[1], vb, pa0, pa1, pa2, pa3); pv_one<2>(od[2], vb, pa0, pa1, pa2, pa3); pv_one<3>(od[3], vb, pa0, pa1, pa2, pa3);
        }
#pragma unroll
        for (int r = 0; r < 8; ++r) { const int k1 = 16 * wid + crow(r, hi); const f32x2 tw = TW[(n2 * k1) & 8191]; const float tr = tw.x, ti = -tw.y;
            bf16_t* yp = YP + ((size_t)(b * 128 + k1) * 128 + n2) * 256 + 128 * ct + r32;
#pragma unroll
            for (int d0 = 0; d0 < 4; ++d0) { const float yr = od[d0][r], yi = od[d0][r + 8];
                yp[32 * d0] = f2bf(yr * tr - yi * ti); yp[64 * 256 + 32 * d0] = f2bf(yr * ti + yi * tr); } }
    }
    __syncthreads();
}
constexpr int ZP = 520;
__device__ __forceinline__ void fft2_item(const bf16_t* yblk, int tok0, int tokstride, float norm, const bf16_t* R64, const bf16_t* WF, bf16_t* CAT, float* SSG, char* lds) {
    const int tid = opaque_tid(), wid = tid >> 6, lane = tid & 63, r32 = lane & 31, hi = lane >> 5;
    bf16_t* Z = (bf16_t*)(lds + 65536);
#pragma unroll
    for (int kt = 0; kt < 2; ++kt)
#pragma unroll
        for (int ct = 0; ct < 2; ++ct) stage_vtile(lds + (kt * 2 + ct) * 16384, yblk + (size_t)(64 * kt) * 256 + 128 * ct, 256);
    __syncthreads();
    { const int rb = wid & 3, ct = wid >> 2;
      f32x16 od[4]; od[0] = f32x16{}; od[1] = f32x16{}; od[2] = f32x16{}; od[3] = f32x16{};
#pragma unroll
      for (int kt = 0; kt < 2; ++kt) {
          const bf16_t* ar = R64 + (size_t)(32 * rb + r32) * 128 + 64 * kt + 8 * hi;
          const bf16x8 pa0 = *(const bf16x8*)(ar), pa1 = *(const bf16x8*)(ar + 16), pa2 = *(const bf16x8*)(ar + 32), pa3 = *(const bf16x8*)(ar + 48);
          const int vb = (int)(uintptr_t)(lds + (kt * 2 + ct) * 16384) + v_rd_base(lane);
          pv_one<0>(od[0], vb, pa0, pa1, pa2, pa3); pv_one<1>(od[1], vb, pa0, pa1, pa2, pa3); pv_one<2>(od[2], vb, pa0, pa1, pa2, pa3); pv_one<3>(od[3], vb, pa0, pa1, pa2, pa3);
      }
#pragma unroll
      for (int r = 0; r < 8; ++r) { bf16_t* zr = Z + (size_t)(16 * rb + crow(r, hi)) * ZP + 128 * ct + r32;
#pragma unroll
          for (int d0 = 0; d0 < 4; ++d0) { zr[32 * d0] = f2bf(od[d0][r]); zr[256 + 32 * d0] = f2bf(od[d0][r + 8]); } }
    }
    __syncthreads();
    { const int rb2 = wid & 1, cb = wid >> 1, ct2 = cb >> 1, d0a = 2 * (cb & 1);
      f32x16 o2[2]; o2[0] = f32x16{}; o2[1] = f32x16{};
      const int sr = tid >> 4, sc = (tid & 15) * 8;
      bf16x8 wq[4][4];
#define WF_LOAD(t) do { const bf16_t* s_ = WF + (size_t)(64 * (t) + sr) * 256 + sc; wq[(t) & 3][0] = *(const bf16x8*)s_; wq[(t) & 3][1] = *(const bf16x8*)(s_ + 32 * 256); \
                        wq[(t) & 3][2] = *(const bf16x8*)(s_ + 128); wq[(t) & 3][3] = *(const bf16x8*)(s_ + 32 * 256 + 128); } while (0)
#define WF_WRITE(t) do { char* nb_ = lds + ((t) & 1) * 32768; *(bf16x8*)(nb_ + v_st(sr, sc)) = wq[(t) & 3][0]; *(bf16x8*)(nb_ + v_st(32 + sr, sc)) = wq[(t) & 3][1]; \
                         *(bf16x8*)(nb_ + 16384 + v_st(sr, sc)) = wq[(t) & 3][2]; *(bf16x8*)(nb_ + 16384 + v_st(32 + sr, sc)) = wq[(t) & 3][3]; } while (0)
      WF_LOAD(0); WF_LOAD(1); WF_LOAD(2); WF_LOAD(3);
      WF_WRITE(0);
      __syncthreads();
#pragma unroll
      for (int kt = 0; kt < 8; ++kt) {
          if (kt + 1 < 8) WF_WRITE(kt + 1);
          if (kt + 4 < 8) WF_LOAD(kt + 4);
          const bf16_t* ar = Z + (size_t)(32 * rb2 + r32) * ZP + 64 * kt + 8 * hi;
          const bf16x8 pa0 = *(const bf16x8*)(ar), pa1 = *(const bf16x8*)(ar + 16), pa2 = *(const bf16x8*)(ar + 32), pa3 = *(const bf16x8*)(ar + 48);
          const int vb = (int)(uintptr_t)(lds + (kt & 1) * 32768 + ct2 * 16384) + v_rd_base(lane) + d0a * 512;
          pv_one<0>(o2[0], vb, pa0, pa1, pa2, pa3); pv_one<1>(o2[1], vb, pa0, pa1, pa2, pa3);
          __syncthreads();
      }
#undef WF_LOAD
#undef WF_WRITE
#pragma unroll
      for (int r = 0; r < 16; ++r) { const int k2 = 32 * rb2 + crow(r, hi); const size_t tok = (size_t)tok0 + (size_t)tokstride * k2;
          const float v0 = o2[0][r] * norm, v1 = o2[1][r] * norm;
          bf16_t* cp = CAT + tok * 1024 + CC_C + 64 * cb + r32; cp[0] = f2bf(v0); cp[32] = f2bf(v1);
          float s2 = v0 * v0 + v1 * v1;
          s2 += __shfl_xor(s2, 1); s2 += __shfl_xor(s2, 2); s2 += __shfl_xor(s2, 4); s2 += __shfl_xor(s2, 8); s2 += __shfl_xor(s2, 16);
          if (r32 == 0) SSG[tok * 16 + 8 + cb] = s2; }
    }
    __syncthreads();
}

__device__ __forceinline__ void phase_mergenorm(const Params& p, int l, int ntok, bf16_t* OUT) {
    const int tid_ = opaque_tid(); const int lane = tid_ & 63, gw = blockIdx.x * NWAVES + (tid_ >> 6), NGW = gridDim.x * NWAVES;
    bf16_t* CAT = (bf16_t*)(p.ws + WS_CAT); const float* SSG = (const float*)(p.ws + WS_SSG); const float* gn = p.in[I_GRPN] + l * 1024;
    f32x4 gv[2][2];
#pragma unroll
    for (int j = 0; j < 2; ++j) { gv[j][0] = *(const f32x4*)(gn + 8 * lane + 512 * j); gv[j][1] = *(const f32x4*)(gn + 8 * lane + 512 * j + 4); }
    int tok = gw; f32x4 ss; u32x4 w[2];
#define SSG_LOAD(t) ({ const float* q_ = SSG + (size_t)(t) * 16; const f32x4 a_ = *(const f32x4*)q_, b_ = *(const f32x4*)(q_ + 4), c_ = *(const f32x4*)(q_ + 8), d_ = *(const f32x4*)(q_ + 12); \
        (f32x4){(a_[0] + a_[1]) + (a_[2] + a_[3]), (b_[0] + b_[1]) + (b_[2] + b_[3]), (c_[0] + c_[1]) + (c_[2] + c_[3]), (d_[0] + d_[1]) + (d_[2] + d_[3])}; })
#define MN_LOAD(SS, W, t) do { SS = SSG_LOAD(t); W[0] = *(const u32x4*)(CAT + (size_t)(t) * 1024 + 8 * lane); W[1] = *(const u32x4*)(CAT + (size_t)(t) * 1024 + 512 + 8 * lane); } while (0)
    f32x4 ss1, ss2; u32x4 w1[2], w2[2];
    if (tok < ntok) MN_LOAD(ss, w, tok);
    if (tok + NGW < ntok) MN_LOAD(ss1, w1, tok + NGW);
    if (tok + 2 * NGW < ntok) MN_LOAD(ss2, w2, tok + 2 * NGW);
    while (tok < ntok) {
        const int t3 = tok + 3 * NGW; f32x4 ss3; u32x4 w3[2];
        if (t3 < ntok) MN_LOAD(ss3, w3, t3);
#pragma unroll
        for (int j = 0; j < 2; ++j) { const int c = 8 * lane + 512 * j, g = c >> 8; const float rstd = rsqrtf(ss[g] * (1.f / 256.f) + EPS);
            u32x4 x = w[j]; const f32x4 g0 = gv[j][0], g1 = gv[j][1];
            x.x = pk2(bflo(x.x) * rstd * g0[0], bfhi(x.x) * rstd * g0[1]); x.y = pk2(bflo(x.y) * rstd * g0[2], bfhi(x.y) * rstd * g0[3]);
            x.z = pk2(bflo(x.z) * rstd * g1[0], bfhi(x.z) * rstd * g1[1]); x.w = pk2(bflo(x.w) * rstd * g1[2], bfhi(x.w) * rstd * g1[3]);
            *(u32x4*)(OUT + (size_t)tok * 1024 + c) = x; }
        ss = ss1; w[0] = w1[0]; w[1] = w1[1]; ss1 = ss2; w1[0] = w2[0]; w1[1] = w2[1]; ss2 = ss3; w2[0] = w3[0]; w2[1] = w3[1]; tok += NGW;
    }
#undef MN_LOAD
}
__device__ __forceinline__ void phase_router(const Params& p, int l, int ntok, const bf16_t* xl, const float* xc, LAS unsigned char* ldsl, bool conv) {
    const int tid = opaque_tid(), lane = tid & 63, gw = blockIdx.x * NWAVES + (tid >> 6), NGW = gridDim.x * NWAVES;
    LAS float* rw = (LAS float*)ldsl;
    for (int i = tid; i < 1024 * 16; i += NTHR) { const int k = i >> 4, e = i & 15; rw[k * 20 + ((((e >> 2) + (k >> 4)) & 3) << 2) + (e & 3)] = p.in[I_ROUTER][(size_t)l * 1024 * 16 + i]; }
    __syncthreads();
    const float* mods = (const float*)(p.ws + WS_MODS) + (size_t)l * 5 * 6144; bf16_t* H = (bf16_t*)(p.ws + WS_H); float* aff = (float*)(p.ws + WS_AFF);
    const float* g2 = p.in[I_N2G] + l * 1024;
    const int rot = (lane >> 2) & 3;
    const int eidx = ((lane >> 5) & 1) * 8 + ((lane >> 4) & 1) * 4 + ((lane >> 3) & 1) * 2 + ((lane >> 2) & 1);
    const int cwave = tid >> 6; LAS float* cscr = (LAS float*)(ldsl + 81920 + (cwave < 6 ? cwave : 0) * 8448);
    int cit = (conv && cwave < 6) ? (int)blockIdx.x * 6 + cwave : EXI_TOTAL;
    ModCoef mc; int curb = -1;
    int tok = gw; f32x4 v[4];
    if (tok < ntok) load_res_row(v, tok, xl, xc, lane);
    while (tok < ntok) {
        const int ntk = tok + NGW; f32x4 vn[4];
        if (ntk < ntok) load_res_row(vn, ntk, xl, xc, lane);
        const int bidx = (tok < TL) ? (tok >> 13) : 4;
        if (bidx != curb) { const float* mb = mods + (size_t)bidx * 6144; load_modcoef(mc, g2, mb + 3072, mb + 4096, lane); curb = bidx; }
        const float rstd = row_rstd(v);
        float acc[16];
#pragma unroll
        for (int e = 0; e < 16; ++e) acc[e] = 0.f;
#pragma unroll
        for (int j = 0; j < 4; ++j) { v[j] = v[j] * rstd * mc.ca[j] + mc.cb[j];
            u32x2 w; w.x = pk2(v[j][0], v[j][1]); w.y = pk2(v[j][2], v[j][3]); *(u32x2*)(H + (size_t)tok * 1024 + 4 * lane + 256 * j) = w; }
#define RW_LOAD(W, g) do { _Pragma("unroll") for (int ii = 0; ii < 2; ++ii) { const LAS float* wr_ = rw + (4 * lane + 256 * ((g) >> 1) + 2 * ((g) & 1) + ii) * 20; \
            _Pragma("unroll") for (int q = 0; q < 4; ++q) W[ii * 4 + q] = *(const LAS f32x4*)(wr_ + (((q + rot) & 3) << 2)); } } while (0)
#define RW_FMA(W, g) do { _Pragma("unroll") for (int ii = 0; ii < 2; ++ii) { const float hv = v[(g) >> 1][2 * ((g) & 1) + ii]; \
            _Pragma("unroll") for (int q = 0; q < 4; ++q) { const f32x4 ww = W[ii * 4 + q]; acc[4 * q + 0] += hv * ww[0]; acc[4 * q + 1] += hv * ww[1]; acc[4 * q + 2] += hv * ww[2]; acc[4 * q + 3] += hv * ww[3]; } } } while (0)
        { f32x4 wA[8], wB[8];
          RW_LOAD(wA, 0);
          RW_LOAD(wB, 1); asm volatile("" ::: "memory"); RW_FMA(wA, 0); asm volatile("" ::: "memory");
          RW_LOAD(wA, 2); asm volatile("" ::: "memory"); RW_FMA(wB, 1); asm volatile("" ::: "memory");
          RW_LOAD(wB, 3); asm volatile("" ::: "memory"); RW_FMA(wA, 2); asm volatile("" ::: "memory");
          RW_LOAD(wA, 4); asm volatile("" ::: "memory"); RW_FMA(wB, 3); asm volatile("" ::: "memory");
          RW_LOAD(wB, 5); asm volatile("" ::: "memory"); RW_FMA(wA, 4); asm volatile("" ::: "memory");
          RW_LOAD(wA, 6); asm volatile("" ::: "memory"); RW_FMA(wB, 5); asm volatile("" ::: "memory");
          RW_LOAD(wB, 7); asm volatile("" ::: "memory"); RW_FMA(wA, 6); asm volatile("" ::: "memory");
          RW_FMA(wB, 7); }
#undef RW_LOAD
#undef RW_FMA
        float t8[8], t4[4], t2[2], lg;
#pragma unroll
        for (int i = 0; i < 8; ++i) { const bool up = (lane & 32) != 0; const float snd = up ? acc[i] : acc[i + 8]; const float rcv = xchg32(snd); t8[i] = (up ? acc[i + 8] : acc[i]) + rcv; }
#pragma unroll
        for (int i = 0; i < 4; ++i) { const bool up = (lane & 16) != 0; const float snd = up ? t8[i] : t8[i + 4]; const float rcv = __shfl_xor(snd, 16); t4[i] = (up ? t8[i + 4] : t8[i]) + rcv; }
#pragma unroll
        for (int i = 0; i < 2; ++i) { const bool up = (lane & 8) != 0; const float snd = up ? t4[i] : t4[i + 2]; const float rcv = xchg8(snd); t2[i] = (up ? t4[i + 2] : t4[i]) + rcv; }
        { const bool up = (lane & 4) != 0; const float snd = up ? t2[0] : t2[1]; const float rcv = __shfl_xor(snd, 4); lg = (up ? t2[1] : t2[0]) + rcv; }
        lg += xchg2(lg); lg += xchg1(lg);
        float mx = lg;
        mx = fmaxf(mx, __shfl_xor(mx, 4)); mx = fmaxf(mx, xchg8(mx)); mx = fmaxf(mx, __shfl_xor(mx, 16)); mx = fmaxf(mx, xchg32(mx));
        const float ex = expf(lg - mx); float sum = ex;
        sum += __shfl_xor(sum, 4); sum += xchg8(sum); sum += __shfl_xor(sum, 16); sum += xchg32(sum);
        if ((lane & 3) == 0) aff[(size_t)tok * 16 + eidx] = ex / sum;
        if (conv && cit < EXI_TOTAL) { expert_weight_item(p, 1, cit, cscr, lane); cit += 6 * (int)gridDim.x; }
#pragma unroll
        for (int j = 0; j < 4; ++j) v[j] = vn[j];
        tok = ntk;
    }
    if (conv) while (cit < EXI_TOTAL) { expert_weight_item(p, 1, cit, cscr, lane); cit += 6 * (int)gridDim.x; }
    __syncthreads();
}
__device__ __forceinline__ unsigned block_exscan(unsigned x, LAS unsigned* wtot, int lane, int wid) {
    unsigned v = x;
#pragma unroll
    for (int o = 1; o < 64; o <<= 1) { const unsigned y = __shfl_up(v, o); if (lane >= o) v += y; }
    if (lane == 63) wtot[wid] = v;
    __syncthreads();
    unsigned base = 0;
    for (int w = 0; w < wid; ++w) base += wtot[w];
    __syncthreads();
    return base + v - x;
}
template <int CH>
__device__ __forceinline__ void topk_item(const Params& p, int tokbase, int n, int e, int K, int slotbase, LAS unsigned char* ldsl) {
    const int tid = opaque_tid(), lane = tid & 63, wid = tid >> 6;
    LAS unsigned* hist = (LAS unsigned*)ldsl; LAS unsigned* wtot = hist + 256; LAS unsigned* misc = wtot + 16;
    const float* aff = (const float*)(p.ws + WS_AFF); int* seltok = (int*)(p.ws + WS_SELTOK); float* selgate = (float*)(p.ws + WS_SELGATE); int* slotof = (int*)(p.ws + WS_SLOTOF) + e;
    const int nact = n / CH;
    unsigned kr[CH];
#pragma unroll
    for (int i = 0; i < CH; ++i) kr[i] = (tid < nact) ? __float_as_uint(aff[(size_t)(tokbase + tid * CH + i) * 16 + e]) : 0u;
    if (tid == 0) { unsigned z_ = 0u, k_ = (unsigned)K; asm volatile("" : "+v"(z_), "+v"(k_)); misc[0] = z_; misc[1] = k_; }
    __syncthreads();
    for (int ps = 3; ps >= 0; --ps) {
        if (tid < 256) hist[tid] = 0u;
        __syncthreads();
        const unsigned prefix = misc[0]; const unsigned mask = (ps == 3) ? 0u : (0xFFFFFFFFu << (8 * (ps + 1)));
        if (tid < nact) {
#pragma unroll
          for (int i = 0; i < CH; ++i) { const unsigned key = kr[i]; if (((key ^ prefix) & mask) == 0u) __hip_atomic_fetch_add(&hist[(key >> (8 * ps)) & 255u], 1u, __ATOMIC_RELAXED, __HIP_MEMORY_SCOPE_WORKGROUP); } }
        __syncthreads();
        if (wid == 0) { const unsigned need = misc[1];
            unsigned hq[4];
#pragma unroll
            for (int j = 0; j < 4; ++j) hq[j] = hist[255 - 4 * lane - j];
            const unsigned tot = hq[0] + hq[1] + hq[2] + hq[3]; unsigned inc = tot;
#pragma unroll
            for (int o = 1; o < 64; o <<= 1) { const unsigned y = __shfl_up(inc, o); if (lane >= o) inc += y; }
            const unsigned exc = inc - tot;
            if (exc < need && inc >= need) { unsigned cum = exc; int j = 0;
                for (; j < 3; ++j) { if (cum + hq[j] >= need) break; cum += hq[j]; }
                misc[0] = prefix | ((unsigned)(255 - 4 * lane - j) << (8 * ps)); misc[1] = need - cum; } }
        __syncthreads();
    }
    const unsigned T = misc[0], need = misc[1];
    unsigned cgt = 0u, ceq = 0u;
    if (tid < nact) {
#pragma unroll
        for (int i = 0; i < CH; ++i) { const unsigned key = kr[i]; cgt += (key > T) ? 1u : 0u; ceq += (key == T) ? 1u : 0u; } }
    const unsigned eqb = block_exscan(ceq, wtot, lane, wid);
    const unsigned teq = (eqb >= need) ? 0u : min(need - eqb, ceq);
    unsigned pos = block_exscan(cgt + teq, wtot, lane, wid);
    if (tid < nact) { unsigned es = 0u;
#pragma unroll
        for (int i = 0; i < CH; ++i) { const int t = tid * CH + i; const unsigned key = kr[i]; bool take = key > T;
            if (key == T) { take = (eqb + es) < need; ++es; }
            if (take) { const int slot = slotbase + (int)pos; ++pos; seltok[slot] = tokbase + t; selgate[slot] = __uint_as_float(key); slotof[(size_t)(tokbase + t) * 16] = slot; }
            else slotof[(size_t)(tokbase + t) * 16] = -1; } }
    __syncthreads();
}
__device__ __forceinline__ void phase_gather(const Params& p, int nslot) {
    const int tid_ = opaque_tid(); const int lane = tid_ & 63, gw = blockIdx.x * NWAVES + (tid_ >> 6), NGW = gridDim.x * NWAVES;
    const bf16_t* H = (const bf16_t*)(p.ws + WS_H); bf16_t* XS = (bf16_t*)(p.ws + WS_XS); const int* seltok = (const int*)(p.ws + WS_SELTOK);
    for (int s0 = gw * 4; s0 < nslot; s0 += NGW * 4) {
        int tk[4]; u32x4 a[4], b[4];
#pragma unroll
        for (int i = 0; i < 4; ++i) tk[i] = seltok[s0 + i];
#pragma unroll
        for (int i = 0; i < 4; ++i) { a[i] = *(const u32x4*)(H + (size_t)tk[i] * 1024 + 8 * lane); b[i] = *(const u32x4*)(H + (size_t)tk[i] * 1024 + 512 + 8 * lane); }
#pragma unroll
        for (int i = 0; i < 4; ++i) { *(u32x4*)(XS + (size_t)(s0 + i) * 1024 + 8 * lane) = a[i]; *(u32x4*)(XS + (size_t)(s0 + i) * 1024 + 512 + 8 * lane) = b[i]; }
    }
}
__device__ __forceinline__ void phase_combine(const Params& p, int l, int ntok, const bf16_t* xl, const float* xc, bf16_t* xlo, float* xco, float* fin, bf16_t* H) {
    const int tid_ = opaque_tid(); const int lane = tid_ & 63, gw = blockIdx.x * NWAVES + (tid_ >> 6), NGW = gridDim.x * NWAVES;
    const float* modsl = (const float*)(p.ws + WS_MODS) + (size_t)l * 5 * 6144; const float* modsn = modsl + 5 * 6144;
    const bf16_t* YB = (const bf16_t*)(p.ws + WS_YB); const int* slotof = (const int*)(p.ws + WS_SLOTOF);
    const bool last = (l == 1);
    ModCoef mc; f32x4 gt[4]; int curb = -1;
#define FIRST_PAIR(SL, S0, S1, W0, W1, MR) do { unsigned long long m_ = __ballot((SL) >= 0); S0 = 0; S1 = 0; W0 = 0.f; W1 = 0.f; \
        if (m_) { S0 = __builtin_amdgcn_readlane(SL, __builtin_ctzll(m_)); m_ &= m_ - 1; W0 = 1.f; S1 = S0; } \
        if (m_) { S1 = __builtin_amdgcn_readlane(SL, __builtin_ctzll(m_)); m_ &= m_ - 1; W1 = 1.f; } MR = m_; } while (0)
#define LOAD_PAIR(Q0, Q1, S0, S1) do { const bf16_t* y0_ = YB + (size_t)(S0) * 1024 + 4 * lane; const bf16_t* y1_ = YB + (size_t)(S1) * 1024 + 4 * lane; \
        _Pragma("unroll") for (int j = 0; j < 4; ++j) { Q0[j] = *(const u32x2*)(y0_ + 256 * j); Q1[j] = *(const u32x2*)(y1_ + 256 * j); } } while (0)
    int tok = gw; f32x4 v[4]; int sl = -1, sl1 = -1;
    u32x2 q0[4], q1[4]; int s0 = 0, s1 = 0; float w0 = 0.f, w1 = 0.f; unsigned long long mrest = 0;
    if (tok < ntok) { load_res_row(v, tok, xl, xc, lane); sl = (lane < 16) ? slotof[(size_t)tok * 16 + lane] : -1; }
    if (tok + NGW < ntok) sl1 = (lane < 16) ? slotof[(size_t)(tok + NGW) * 16 + lane] : -1;
    FIRST_PAIR(sl, s0, s1, w0, w1, mrest);
    LOAD_PAIR(q0, q1, s0, s1);
    while (tok < ntok) {
        const int ntk = tok + NGW, ntk2 = ntk + NGW; f32x4 vn[4]; int sl2 = -1;
        if (ntk < ntok) load_res_row(vn, ntk, xl, xc, lane);
        if (ntk2 < ntok) sl2 = (lane < 16) ? slotof[(size_t)ntk2 * 16 + lane] : -1;
        u32x2 q0n[4], q1n[4]; int s0n, s1n; float w0n, w1n; unsigned long long mrestn;
        FIRST_PAIR(sl1, s0n, s1n, w0n, w1n, mrestn);
        LOAD_PAIR(q0n, q1n, s0n, s1n);
        const int bidx = (tok < TL) ? (tok >> 13) : 4;
        f32x4 a[4];
#pragma unroll
        for (int j = 0; j < 4; ++j) { a[j][0] = w0 * bflo(q0[j].x); a[j][1] = w0 * bfhi(q0[j].x); a[j][2] = w0 * bflo(q0[j].y); a[j][3] = w0 * bfhi(q0[j].y);
            a[j][0] += w1 * bflo(q1[j].x); a[j][1] += w1 * bfhi(q1[j].x); a[j][2] += w1 * bflo(q1[j].y); a[j][3] += w1 * bfhi(q1[j].y); }
        unsigned long long m = mrest;
        while (m) {
            const int e0 = __builtin_ctzll(m); m &= m - 1; const int t0 = __builtin_amdgcn_readlane(sl, e0);
            int t1 = t0; float u1 = 0.f;
            if (m) { const int e1 = __builtin_ctzll(m); m &= m - 1; t1 = __builtin_amdgcn_readlane(sl, e1); u1 = 1.f; }
            u32x2 r0[4], r1[4];
            LOAD_PAIR(r0, r1, t0, t1);
#pragma unroll
            for (int j = 0; j < 4; ++j) { a[j][0] += bflo(r0[j].x); a[j][1] += bfhi(r0[j].x); a[j][2] += bflo(r0[j].y); a[j][3] += bfhi(r0[j].y);
                a[j][0] += u1 * bflo(r1[j].x); a[j][1] += u1 * bfhi(r1[j].x); a[j][2] += u1 * bflo(r1[j].y); a[j][3] += u1 * bfhi(r1[j].y); }
        }
        if (bidx != curb) { curb = bidx;
#pragma unroll
            for (int j = 0; j < 4; ++j) gt[j] = *(const f32x4*)(modsl + (size_t)bidx * 6144 + 5120 + 4 * lane + 256 * j);
            if (last) {
#pragma unroll
                for (int j = 0; j < 4; ++j) mc.ca[j] = *(const f32x4*)(p.in[I_FINAL] + 4 * lane + 256 * j);
            } else { const float* mb = modsn + (size_t)bidx * 6144; load_modcoef(mc, p.in[I_N1G] + 1024, mb, mb + 1024, lane); } }
#pragma unroll
        for (int j = 0; j < 4; ++j) v[j] = v[j] + gt[j] * a[j];
        const float rstd = row_rstd(v);
        if (last) {
#pragma unroll
            for (int j = 0; j < 4; ++j) *(f32x4*)(fin + (size_t)tok * 1024 + 4 * lane + 256 * j) = v[j] * rstd * mc.ca[j];
        } else {
            if (tok < TL) {
#pragma unroll
                for (int j = 0; j < 4; ++j) { u32x2 w; w.x = pk2(v[j][0], v[j][1]); w.y = pk2(v[j][2], v[j][3]); *(u32x2*)(xlo + (size_t)tok * 1024 + 4 * lane + 256 * j) = w; }
            } else {
#pragma unroll
                for (int j = 0; j < 4; ++j) *(f32x4*)(xco + (size_t)(tok - TL) * 1024 + 4 * lane + 256 * j) = v[j];
            }
            mod_row_store2(v, rstd, mc, H + (size_t)tok * 1024, lane);
        }
#pragma unroll
        for (int j = 0; j < 4; ++j) { v[j] = vn[j]; q0[j] = q0n[j]; q1[j] = q1n[j]; }
        sl = sl1; sl1 = sl2; tok = ntk; w0 = w0n; w1 = w1n; mrest = mrestn;
    }
#undef FIRST_PAIR
#undef LOAD_PAIR
}

constexpr int N_PHASES = 26;
__global__ void __launch_bounds__(NTHR, 2) hybrid_fwd(Params p) {
    unsigned char* const lds = g_lds;
    LAS unsigned char* ldsl = (LAS unsigned char*)g_lds;
    volatile LAS unsigned* MISC = (volatile LAS unsigned*)(ldsl + MISC_OFF);
    const int G = gridDim.x, bx = blockIdx.x, NGW = G * NWAVES, GT = G * NTHR;
#define TIDS() const int tid = opaque_tid(), lane = tid & 63, wave = __builtin_amdgcn_readfirstlane(tid >> 6), gw = bx * NWAVES + wave, gtid = bx * NTHR + tid; (void)lane; (void)gw; (void)gtid
    { TIDS(); for (int u = tid; u < (LDS_BYTES - LDSCTL_OFF) / 4; u += NTHR) ((LAS unsigned*)(ldsl + LDSCTL_OFF))[u] = 0u; }
    __syncthreads();
    unsigned char* ws = p.ws;
    const int lo = p.ph_lo, hi = p.ph_hi;
#if MK_ONE_LAUNCH
    XcdBarrier bar = xcd_barrier_post((unsigned*)(ws + WS_CTL) + 4096, MISC + 8);
    if (lo < -1) cg::this_grid().sync();
#define SEAM(k) do { if (lo <= (k) && (k) + 1 < hi) xcd_barrier(bar); } while (0)
#else
#define SEAM(k) do { } while (0)
#endif
#ifndef DBG_PHASE
#define DBG_PHASE -1
#endif
#ifndef DBG_PHMASK
#define DBG_PHMASK 0
#endif
#define PH_EN(t) ((DBG_PHASE < 0 && DBG_PHMASK == 0) || DBG_PHASE == (t) || ((t) < 32 && ((DBG_PHMASK >> (t)) & 1)))
#ifndef DBG_SUBD
#define DBG_SUBD -1
#endif
#define SUBD_EN(t) (DBG_SUBD < 0 || DBG_SUBD == (t))
#define IN(k) (lo <= (k) && (k) < hi)
#ifndef DBG_REP
#define DBG_REP 0
#endif
#define NREP(bit) (1 + ((DBG_REP >> (bit)) & 1))
    bf16_t* xl = (bf16_t*)(ws + WS_XLB); float* xc = (float*)(ws + WS_XC);
    bf16_t* H = (bf16_t*)(ws + WS_H); bf16_t* P = (bf16_t*)(ws + WS_P); bf16_t* CAT = (bf16_t*)(ws + WS_CAT); float* SSG = (float*)(ws + WS_SSG);

    if (IN(0) && PH_EN(100)) { for (int rep = 0; rep < NREP(12); ++rep) phase_a0(p, ldsl); SEAM(0); }
    if (IN(1) && PH_EN(101)) { for (int rep = 0; rep < NREP(13); ++rep) phase_a1(p); SEAM(1); }
#if MK_ONE_LAUNCH
    if ((DBG_REP >> 14) & 1) for (int xb = 0; xb < 20; ++xb) xcd_barrier(bar);
#endif
    for (int l = 0; l < 2; ++l) {
        const int pb = 2 + 12 * l; const bool wctx = (l == 0);
            asm volatile("s_nop 0\n s_nop 0\n s_nop 0\n s_nop 0\n s_nop 0\n s_nop 0\n s_nop 0\n s_nop 0\n s_nop 0\n s_nop 0\n s_nop 0\n s_nop 0\n s_nop 0\n s_nop 0");
        unsigned char* sw = ws + WS_SMALLW + (size_t)l * SW_BYTES;
        const float* modsl = (const float*)(ws + WS_MODS) + (size_t)l * 5 * 6144;
        if (IN(pb + 0) && PH_EN(0)) {
            pg8::Gemm g{H, 1024, (const bf16_t*)(sw + SW_WIN), 1024}; pg8::Order S; S.init(TA / 256, DINP / 256, G, bx, 256L * 1024, 256L * 1024);
            pg8::EpiStore E{P, DINP, P, DINP, 1 << 30};
            for (int rep = 0; rep < NREP(0); ++rep) pg8::gemm_phase(ldsl, g, S, E);
            SEAM(pb + 0);
        }
        if (IN(pb + 1) && PH_EN(1)) {
            TIDS();
            asm volatile("s_nop 0\n s_nop 0\n s_nop 0\n s_nop 0");
            for (int rep = 0; rep < NREP(11); ++rep) {
            for (int it = bx; it < NBATCH * 64; it += G) fft1_item(p, it >> 6, it & 63, (char*)lds);
            for (int tok = gw; tok < TA; tok += NGW) prep_token(p, l, tok, lane);
            if (wctx) for (int it = gw; it < NBATCH * 4 * 64; it += NGW) fft1_ctx_item(p, it, lane);
            }
            SEAM(pb + 1);
        }
        if (IN(pb + 2) && PH_EN(2)) {
            asm volatile("s_nop 0\n s_nop 0\n s_nop 0\n s_nop 0\n s_nop 0\n s_nop 0\n s_nop 0");
            for (int rep = 0; rep < NREP(1); ++rep) { float* SSGr = rep ? (float*)(ws + WS_SSGD) : SSG;
              pg8::Gemm g{(const bf16_t*)(ws + WS_QCN), 256, (const bf16_t*)(sw + SW_WUQ), 256}; pg8::Order S; S.init(TA / 256, 5, G, bx, 256L * 256, 256L * 256); S.d_mode = 1;
              pg8::EpiD E{pg8::EpiQ{(bf16_t*)(ws + WS_QD), (const float*)(ws + WS_ROPE), (const float*)(ws + WS_ROPE) + 1024},
                          pg8::EpiStore{(bf16_t*)(ws + WS_KNOPE), 256, (bf16_t*)(ws + WS_VD), 256, 1},
                          pg8::EpiPool{CAT, p.in[I_POOLS] + l * 256, SSGr}};
              pg8::gemm_phase(ldsl, g, S, E);
            }
            SEAM(pb + 2);
        }
        if (IN(pb + 3) && PH_EN(3)) {
            asm volatile("s_nop 0\n s_nop 0\n s_nop 0\n s_nop 0\n s_nop 0\n s_nop 0");
#ifndef DBG_SUB
#define DBG_SUB -1
#endif
#define SUB_EN(t) (DBG_SUB < 0 || DBG_SUB == (t))
            for (int rep = 0; rep < NREP(2); ++rep)
            if (SUB_EN(0)) for (int u = bx; u < (wctx ? 272 : 256); u += G) {
                AttnDesc d; int b, h, tok0;
                if (u < 256) { const int xcd = u & 7, j = u >> 3, bh = xcd * 2 + (j >> 4), qb = j & 15; b = bh >> 2; h = bh & 3; tok0 = b * SEQ + qb * 512;
                    d.first_base = b * SEQ; d.n_first = 128; d.second_base = TL + b * CTXL; d.clampmax = 1 << 20; d.NT = 132; d.nrows = 512; }
                else { b = (u - 256) >> 2; h = u & 3; tok0 = TL + b * CTXL; d.first_base = tok0; d.n_first = 4; d.second_base = tok0; d.clampmax = 0; d.NT = 4; d.nrows = 256; }
                d.q_off = (unsigned)(WS_QD + ((size_t)tok0 * 384 + h * 96) * 2); d.ka_off = (unsigned)(WS_KNOPE + (size_t)h * 64 * 2); d.kb_off = (unsigned)WS_KR; d.v_off = (unsigned)(WS_VD + (size_t)h * 64 * 2);
                d.o_off = (unsigned)(WS_CAT + ((size_t)tok0 * 1024 + CC_D + h * 64) * 2); d.ss_off = (unsigned)((rep ? WS_SSGD : WS_SSG) + ((size_t)tok0 * 16 + 12 + h) * 4); d.qy0 = 0; d.R0 = 0;
                mla_unit(d, ws, (char*)lds); }
            for (int rep = 0; rep < NREP(3); ++rep)
            if (SUB_EN(1)) for (int u = bx; u < 512 + G; u += G) {
                if (u >= 512) { u = 512 + (u - 512 + G - 16) % G; if (!wctx || u >= 528) break; }
                TIDS(); NaDesc d; int b, h, tok0;
                if (u < 512) { b = u >> 7; h = (u >> 5) & 3; const int r4 = u & 31; tok0 = b * SEQ + r4 * 256;
                    d.qy0 = 4 * r4; d.R0 = min(max(4 * r4 - 4, 0), 120); d.nrows = min(max(4 * r4 - 1, 0), 120) + 8 - d.R0; d.row_base = b * SEQ + d.R0 * 64; }
                else { const int uc = u - 512; b = uc >> 2; h = uc & 3; tok0 = TL + b * CTXL; d.qy0 = 0; d.R0 = 0; d.nrows = 0; d.row_base = 0; }
                d.ctx_base = TL + b * CTXL;
                float* bt = (float*)((char*)lds + NA_BIAS_OFF);
                for (int i = tid; i < 15 * 64; i += NTHR) { const int dc = (i & 63) - 16; bt[i] = (dc >= 0 && dc < 31) ? p.in[I_NABIAS][((size_t)(l * 4 + h) * 15 + (i >> 6)) * 31 + dc] * 1.4426950408889634f : 0.f; }
                __syncthreads();
                d.q_off = (unsigned)(WS_P + ((size_t)tok0 * DINP + PC_AQ + h * 64) * 2); d.k_off = (unsigned)(WS_P + (size_t)(PC_AK + h * 64) * 2); d.v_off = (unsigned)(WS_P + (size_t)(PC_AV + h * 64) * 2);
                d.o_off = (unsigned)(WS_CAT + ((size_t)tok0 * 1024 + CC_A + h * 64) * 2); d.ss_off = (unsigned)((rep ? WS_SSGD : WS_SSG) + ((size_t)tok0 * 16 + 0 + h) * 4);
                na_unit(d, ws, (char*)lds); }
            for (int rep = 0; rep < NREP(4); ++rep)
            if (SUB_EN(2)) for (int it = bx; it < 512 + G; it += G) {
                if (it >= 512) { it = 512 + (it - 512 + G - 48) % G; if (!wctx || it >= 528) break; }
                const bf16_t* yb; int tok0, tstr; float nrm;
                if (it < 512) { yb = (const bf16_t*)(ws + WS_YP) + (size_t)it * 128 * 256; tok0 = (it >> 7) * SEQ + (it & 127); tstr = 128; nrm = 1.f / sqrtf(8192.f * 64.f); }
                else { const int ic = it - 512; yb = (const bf16_t*)(ws + WS_YP) + YP_CTX_OFF + (size_t)ic * 128 * 256; tok0 = TL + (ic >> 2) * CTXL + (ic & 3); tstr = 4; nrm = 1.f / sqrtf(256.f * 64.f); }
                fft2_item(yb, tok0, tstr, nrm, (const bf16_t*)(ws + WS_R64), (const bf16_t*)(sw + SW_WF), CAT, rep ? (float*)(ws + WS_SSGD) : SSG, (char*)lds); }
            SEAM(pb + 3);
        }
        if (IN(pb + 4) && PH_EN(4)) { if (NREP(15) > 1) phase_mergenorm(p, l, wctx ? TA : TL, (bf16_t*)(ws + WS_R1)); phase_mergenorm(p, l, wctx ? TA : TL, CAT); SEAM(pb + 4); }
        if (IN(pb + 5) && PH_EN(5)) {
            pg8::Gemm g{CAT, 1024, (const bf16_t*)(sw + SW_WOUT), 1024}; pg8::Order S; S.init((wctx ? TA : TL) / 256, 4, G, bx, 256L * 1024, 256L * 1024);
            pg8::EpiRes E{(l == 0) ? p.in[I_X] : (const float*)nullptr, xl, (l == 0) ? p.in[I_CTX] : (const float*)xc, xl, xc, modsl};
            for (int rep = 0; rep < ((l == 0) ? NREP(5) : 1); ++rep) pg8::gemm_phase(ldsl, g, S, E);
            SEAM(pb + 5);
        }
        if (IN(pb + 6) && PH_EN(6)) { for (int rep = 0; rep < NREP(6); ++rep) phase_router(p, l, wctx ? TA : TL, xl, xc, ldsl, l == 1); SEAM(pb + 6); }
        if (IN(pb + 7) && PH_EN(7)) {
            TIDS(); const int nitems = wctx ? 128 : 64;
            for (int rep = 0; rep < NREP(7); ++rep)
            for (int it = bx; it < nitems; it += G) {
                if (it < 64) { const int b = it >> 4, e = it & 15; topk_item<SEQ / NTHR>(p, b * SEQ, SEQ, e, CAPL, (e * NBATCH + b) * CAPL, ldsl); }
                else { const int b = (it - 64) >> 4, e = it & 15; topk_item<1>(p, TL + b * CTXL, CTXL, e, CAPC, NSLOT_L + e * 256 + b * CAPC, ldsl);
                    if (b == 0 && tid < 128) { ((int*)(ws + WS_SELTOK))[NSLOT_L + e * 256 + 128 + tid] = 0; ((float*)(ws + WS_SELGATE))[NSLOT_L + e * 256 + 128 + tid] = 0.f; } }
            }
            SEAM(pb + 7);
        }
        if (IN(pb + 9) && PH_EN(9)) {
            pg8::Gemm g{(const bf16_t*)H, 1024, (const bf16_t*)(ws + WS_WGU), 1024}; pg8::Order S; S.init((wctx ? NSLOT : NSLOT_L) / 256, 8, G, bx, 256L * 1024, 256L * 1024);
            S.e_div = 16; S.e_mul = 2048L * 1024; S.pm_ctx0 = 256;
            pg8::EpiSwiGLU E{(bf16_t*)(ws + WS_HID)};
            for (int rep = 0; rep < NREP(9); ++rep) pg8::gemm_phase<pg8::EpiSwiGLU, true>(ldsl, g, S, E, (const int*)(ws + WS_SELTOK));
            SEAM(pb + 9);
        }
        if (IN(pb + 10) && PH_EN(10)) {
            pg8::Gemm g{(const bf16_t*)(ws + WS_HID), 1024, (const bf16_t*)(ws + WS_WD), 1024}; pg8::Order S; S.init((wctx ? NSLOT : NSLOT_L) / 256, 4, G, bx, 256L * 1024, 256L * 1024);
            S.e_div = 16; S.e_mul = 1024L * 1024; S.pm_ctx0 = 256;
            pg8::EpiGate E{(bf16_t*)(ws + WS_YB), (const float*)(ws + WS_SELGATE)};
            for (int rep = 0; rep < NREP(10); ++rep) pg8::gemm_phase(ldsl, g, S, E);
            SEAM(pb + 10);
        }
        if (IN(pb + 11) && PH_EN(11)) {
            if (NREP(16) > 1) phase_combine(p, l, wctx ? TA : TL, xl, xc, (bf16_t*)(ws + WS_R2), (float*)(ws + WS_R2) + (size_t)TL * 512, (float*)(ws + WS_R2), (bf16_t*)(ws + WS_R2) + (size_t)TA * 2048);
            phase_combine(p, l, wctx ? TA : TL, xl, xc, xl, xc, p.out, H);
            SEAM(pb + 11);
        }
    }
}

extern "C" void kernel_launch(void* const* d_in, const int* in_sizes, int n_in, void* d_out, int out_size, void* d_ws, size_t ws_size, hipStream_t stream) {
    static int grid = 0;
    if (grid == 0) {
        if (n_in != 25 || out_size != TL * DM || ws_size < WS_END) { fprintf(stderr, "kernel_launch: unexpected shapes: n_in %d out %d ws %zu (need %zu)\n", n_in, out_size, ws_size, (size_t)WS_END); grid = -1; return; }
        int dev = 0, cus = 0, per_cu = 0;
        if (hipGetDevice(&dev) != hipSuccess || hipDeviceGetAttribute(&cus, hipDeviceAttributeMultiprocessorCount, dev) != hipSuccess) { grid = -1; return; }
        if (hipFuncSetAttribute((const void*)hybrid_fwd, hipFuncAttributeMaxDynamicSharedMemorySize, LDS_BYTES) != hipSuccess) { fprintf(stderr, "kernel_launch: hipFuncSetAttribute failed\n"); grid = -1; return; }
        if (hipOccupancyMaxActiveBlocksPerMultiprocessor(&per_cu, (const void*)hybrid_fwd, NTHR, LDS_BYTES) != hipSuccess || per_cu < 1) { fprintf(stderr, "kernel_launch: occupancy query says %d\n", per_cu); }
        (void)hipGetLastError();
        grid = cus;
    }
    if (grid < 0) return;
    (void)hipMemsetAsync((char*)d_ws + WS_CTL, 0, CTL_BYTES, stream);
    Params a{};
    for (int i = 0; i < 25; ++i) a.in[i] = (const float*)d_in[i];
    a.out = (float*)d_out; a.ws = (unsigned char*)d_ws;
#if MK_ONE_LAUNCH
    a.ph_lo = 0; a.ph_hi = N_PHASES;
    void* args[] = {&a};
    hipError_t e = hipLaunchCooperativeKernel((const void*)hybrid_fwd, dim3(grid), dim3(NTHR), args, LDS_BYTES, stream);
    if (e != hipSuccess) fprintf(stderr, "kernel_launch: cooperative launch failed: %s (grid %d)\n", hipGetErrorString(e), grid);
#else
    for (int ph = 0; ph < N_PHASES; ++ph) { a.ph_lo = ph; a.ph_hi = ph + 1; hipLaunchKernelGGL(hybrid_fwd, dim3(grid), dim3(NTHR), LDS_BYTES, stream, a); }
    const hipError_t le = hipPeekAtLastError();
    if (le != hipSuccess) fprintf(stderr, "kernel_launch: launch failed: %s\n", hipGetErrorName(le));
#endif
}
```
